# Optimizing an MI355X kernel written in HIP

```python
import jax, jax.numpy as jnp
from jax import lax
import numpy as np

D_MODEL = 2048
BATCH = 4
SEQ = 4096
DEPTH = 2

HEAD_DIM = 128
MOBA_HEADS = 8
MOBA_WIDTH = MOBA_HEADS * HEAD_DIM
MOBA_BLOCK = 256
MOBA_TOPK = 3
MOBA_QCHUNK = 32
DN_HEADS = 8
DN_WIDTH = DN_HEADS * HEAD_DIM
DN_CONV = 4
DN_CHUNK = 64
D_FF = 5632
FFN_CONV = 3
NORM_EPS = 1e-6
IN_SIZES = (MOBA_WIDTH, MOBA_WIDTH, MOBA_WIDTH, 3 * DN_WIDTH, DN_WIDTH, DN_HEADS, DN_HEADS, D_MODEL, D_MODEL)
IN_COLS = sum(IN_SIZES)

kernel_name = "hybrid_moba_gdn_convglu"


def rms_norm(x, gain):
    xf = x.astype(jnp.float32)
    y = xf * lax.rsqrt(jnp.mean(xf * xf, axis=-1, keepdims=True) + NORM_EPS)
    return (y * gain.astype(jnp.float32)).astype(x.dtype)


def l2_norm(x):
    xf = x.astype(jnp.float32)
    return xf * lax.rsqrt(jnp.sum(xf * xf, axis=-1, keepdims=True) + NORM_EPS)


def causal_dwconv(x, w):
    k_width = w.shape[0]
    s = x.shape[1]
    xp = jnp.pad(x, ((0, 0), (k_width - 1, 0), (0, 0)))
    y = xp[:, 0:s] * w[0]
    for i in range(1, k_width):
        y = y + xp[:, i:i + s] * w[i]
    return y


def moba_branch(q, k, v, q_gain, k_gain):
    b, s, _ = q.shape
    shp = (b, s, MOBA_HEADS, HEAD_DIM)
    q = rms_norm(q.reshape(shp), q_gain)
    k = rms_norm(k.reshape(shp), k_gain)
    v = v.reshape(shp)
    sp = -(-s // MOBA_BLOCK) * MOBA_BLOCK
    pad = ((0, 0), (0, sp - s), (0, 0), (0, 0))
    q, k, v = [jnp.pad(t, pad).transpose(0, 2, 1, 3) for t in (q, k, v)]
    nb = sp // MOBA_BLOCK
    topk = min(MOBA_TOPK, nb)
    k_blocks = k.reshape(b, MOBA_HEADS, nb, MOBA_BLOCK, HEAD_DIM)
    v_blocks = v.reshape(b, MOBA_HEADS, nb, MOBA_BLOCK, HEAD_DIM)
    k_mean = jnp.mean(k_blocks.astype(jnp.float32), axis=3)
    scale = HEAD_DIM ** -0.5
    gather = jax.vmap(jax.vmap(lambda blocks, idx: blocks[idx]))
    block_ids = jnp.arange(nb)
    q_offs = jnp.arange(MOBA_QCHUNK)
    k_offs = jnp.arange(MOBA_BLOCK)

    def chunk(c):
        start = c * MOBA_QCHUNK
        qc = lax.dynamic_slice_in_dim(q, start, MOBA_QCHUNK, axis=2)
        qblk = start // MOBA_BLOCK
        gate = jnp.einsum('bhqd,bhnd->bhqn', qc.astype(jnp.float32), k_mean)
        gate = jnp.where(block_ids < qblk, gate, -jnp.inf)
        _, idx = lax.top_k(gate, topk)
        valid = idx < qblk
        k_sel = gather(k_blocks, idx)
        v_sel = gather(v_blocks, idx)
        s_sel = jnp.einsum('bhqd,bhqnkd->bhqnk', qc, k_sel).astype(jnp.float32) * scale
        s_sel = jnp.where(valid[..., None], s_sel, -jnp.inf).reshape(b, MOBA_HEADS, MOBA_QCHUNK, topk * MOBA_BLOCK)
        k_own = lax.dynamic_slice_in_dim(k, qblk * MOBA_BLOCK, MOBA_BLOCK, axis=2)
        v_own = lax.dynamic_slice_in_dim(v, qblk * MOBA_BLOCK, MOBA_BLOCK, axis=2)
        s_own = jnp.einsum('bhqd,bhkd->bhqk', qc, k_own).astype(jnp.float32) * scale
        causal = (qblk * MOBA_BLOCK + k_offs)[None, :] <= (start + q_offs)[:, None]
        s_own = jnp.where(causal, s_own, -jnp.inf)
        p = jax.nn.softmax(jnp.concatenate([s_sel, s_own], axis=-1), axis=-1)
        p_sel = p[..., :topk * MOBA_BLOCK].reshape(b, MOBA_HEADS, MOBA_QCHUNK, topk, MOBA_BLOCK).astype(v.dtype)
        p_own = p[..., topk * MOBA_BLOCK:].astype(v.dtype)
        return (jnp.einsum('bhqnk,bhqnkd->bhqd', p_sel, v_sel)
                + jnp.einsum('bhqk,bhkd->bhqd', p_own, v_own))

    out = lax.map(chunk, jnp.arange(sp // MOBA_QCHUNK))
    out = out.transpose(1, 0, 3, 2, 4).reshape(b, sp, MOBA_WIDTH)
    return out[:, :s]


def chunk_gated_delta_rule(q, k, v, g, beta):
    b, s, h, dk = q.shape
    dv = v.shape[-1]
    c = DN_CHUNK
    nc = s // c
    q, k, v = [t.transpose(0, 2, 1, 3).reshape(b, h, nc, c, -1) for t in (q, k, v)]
    g, beta = [t.transpose(0, 2, 1).reshape(b, h, nc, c) for t in (g, beta)]
    G = jnp.cumsum(g, axis=-1)
    tril = jnp.tril(jnp.ones((c, c), bool))
    strict = jnp.tril(jnp.ones((c, c), bool), -1)
    decay = jnp.exp(jnp.where(tril, G[..., :, None] - G[..., None, :], -jnp.inf))
    kb = k * beta[..., None]
    m = jnp.einsum('bhnck,bhnsk->bhncs', kb, k) * decay
    lmat = jnp.where(strict, m, 0.0) + jnp.eye(c, dtype=m.dtype)
    u = lax.linalg.triangular_solve(lmat, v * beta[..., None], left_side=True, lower=True, unit_diagonal=True)
    w = lax.linalg.triangular_solve(lmat, kb * jnp.exp(G)[..., None], left_side=True, lower=True, unit_diagonal=True)
    attn = jnp.einsum('bhnck,bhnsk->bhncs', q, k) * decay
    qg = q * jnp.exp(G)[..., None]
    kd = k * jnp.exp(G[..., -1:] - G)[..., None]
    glast = jnp.exp(G[..., -1])
    xs = tuple(jnp.moveaxis(t, 2, 0) for t in (u, w, attn, qg, kd, glast))

    def step(state, inp):
        u_c, w_c, a_c, qg_c, kd_c, gl_c = inp
        v_new = u_c - jnp.einsum('bhck,bhkv->bhcv', w_c, state)
        o_c = jnp.einsum('bhck,bhkv->bhcv', qg_c, state) + jnp.einsum('bhcs,bhsv->bhcv', a_c, v_new)
        state = state * gl_c[..., None, None] + jnp.einsum('bhck,bhcv->bhkv', kd_c, v_new)
        return state, o_c

    state0 = jnp.zeros((b, h, dk, dv), jnp.float32)
    _, o = lax.scan(step, state0, xs)
    return o.transpose(1, 0, 3, 2, 4).reshape(b, s, h, dv)


def deltanet_branch(qkv, z, b_in, a_in, conv_w, a_log, dt_bias, out_gain):
    b, s, _ = qkv.shape
    qkv = jax.nn.silu(causal_dwconv(qkv, conv_w))
    q, k, v = jnp.split(qkv, 3, axis=-1)
    shp = (b, s, DN_HEADS, HEAD_DIM)
    q = l2_norm(q.reshape(shp)) * (HEAD_DIM ** -0.5)
    k = l2_norm(k.reshape(shp))
    v = v.reshape(shp).astype(jnp.float32)
    beta = jax.nn.sigmoid(b_in.astype(jnp.float32))
    g = -jnp.exp(a_log.astype(jnp.float32)) * jax.nn.softplus(a_in.astype(jnp.float32) + dt_bias.astype(jnp.float32))
    o = chunk_gated_delta_rule(q, k, v, g, beta)
    o = rms_norm(o, out_gain) * jax.nn.silu(z.reshape(shp).astype(jnp.float32))
    return o.reshape(b, s, DN_WIDTH).astype(qkv.dtype)


def conv_glu(h, w_in, conv_w, conv_b, w_down):
    gate, up = jnp.split(h @ w_in, 2, axis=-1)
    gate = causal_dwconv(gate, conv_w) + conv_b
    return (jax.nn.silu(gate) * up) @ w_down


def setup_inputs(seed: int = 0) -> dict:
    key = jax.random.key(seed)
    ks = jax.random.split(key, 20)

    def nrm(k, shape, scale):
        return jax.random.normal(k, shape, jnp.float32) * scale

    dt = jnp.exp(jax.random.uniform(ks[8], (DEPTH, DN_HEADS), jnp.float32, np.log(1e-3), np.log(1e-1)))
    return {
        "x": nrm(ks[0], (BATCH, SEQ, D_MODEL), 1.0),
        "attn_norm": 1.0 + nrm(ks[1], (DEPTH, D_MODEL), 0.02),
        "w_in": nrm(ks[2], (DEPTH, D_MODEL, IN_COLS), D_MODEL ** -0.5),
        "moba_q_norm": 1.0 + nrm(ks[3], (DEPTH, HEAD_DIM), 0.02),
        "moba_k_norm": 1.0 + nrm(ks[4], (DEPTH, HEAD_DIM), 0.02),
        "dn_conv": nrm(ks[5], (DEPTH, DN_CONV, 3 * DN_WIDTH), DN_CONV ** -0.5),
        "dn_a_log": jnp.log(jax.random.uniform(ks[6], (DEPTH, DN_HEADS), jnp.float32, 1.0, 16.0)),
        "dn_dt_bias": dt + jnp.log(-jnp.expm1(-dt)),
        "dn_out_norm": 1.0 + nrm(ks[7], (DEPTH, HEAD_DIM), 0.02),
        "w_branch_a": nrm(ks[9], (DEPTH, MOBA_WIDTH, D_MODEL), MOBA_WIDTH ** -0.5),
        "w_branch_b": nrm(ks[10], (DEPTH, DN_WIDTH, D_MODEL), DN_WIDTH ** -0.5),
        "w_out": nrm(ks[11], (DEPTH, D_MODEL, D_MODEL), D_MODEL ** -0.5),
        "ffn_norm": 1.0 + nrm(ks[12], (DEPTH, D_MODEL), 0.02),
        "w_ffn_in": nrm(ks[13], (DEPTH, D_MODEL, 2 * D_FF), D_MODEL ** -0.5),
        "ffn_conv": nrm(ks[14], (DEPTH, FFN_CONV, D_FF), FFN_CONV ** -0.5),
        "ffn_conv_bias": nrm(ks[15], (DEPTH, D_FF), 0.01),
        "w_ffn_down": nrm(ks[16], (DEPTH, D_FF, D_MODEL), D_FF ** -0.5),
    }


def reference(x, attn_norm, w_in, moba_q_norm, moba_k_norm, dn_conv, dn_a_log, dn_dt_bias, dn_out_norm,
              w_branch_a, w_branch_b, w_out, ffn_norm, w_ffn_in, ffn_conv, ffn_conv_bias, w_ffn_down):
    splits = [int(v) for v in np.cumsum(IN_SIZES)[:-1]]
    for l in range(DEPTH):
        h = rms_norm(x, attn_norm[l])
        proj = h @ w_in[l]
        mq, mk, mv, dqkv, dz, db, da, ga, gb = jnp.split(proj, splits, axis=-1)
        y_a = moba_branch(mq, mk, mv, moba_q_norm[l], moba_k_norm[l])
        y_b = deltanet_branch(dqkv, dz, db, da, dn_conv[l], dn_a_log[l], dn_dt_bias[l], dn_out_norm[l])
        merged = jax.nn.sigmoid(ga) * (y_a @ w_branch_a[l]) + jax.nn.sigmoid(gb) * (y_b @ w_branch_b[l])
        x = x + merged @ w_out[l]
        h = rms_norm(x, ffn_norm[l])
        x = x + conv_glu(h, w_ffn_in[l], ffn_conv[l], ffn_conv_bias[l], w_ffn_down[l])
    return x
```

```cpp
#include <hip/hip_runtime.h>
#include <hip/hip_cooperative_groups.h>
#include <cstdio>
#include <cstdint>
namespace cg = cooperative_groups;
namespace pg8 {
#define PG8_LAS __attribute__((address_space(3)))
typedef unsigned short bf16_t;
typedef short bf16x8 __attribute__((ext_vector_type(8)));
typedef float f32x4 __attribute__((ext_vector_type(4)));
typedef unsigned u32x4 __attribute__((ext_vector_type(4)));
constexpr int BM = 256, BK = 64, HALF = 128, HTB = HALF * BK * 2  , STAGE_BYTES = 8 * HTB, NXCD = 8, WGM = 4;

__host__ __device__ __forceinline__ int lds_byte(int r, int c) { const int st = (r >> 4) * 2 + (c >> 5), rr = r & 15, cc = c & 31, ob = rr * 64 + cc * 2; return st * 1024 + (ob ^ (((ob >> 9) & 1) << 5)); }
__host__ __device__ __forceinline__ void stage_rc(int b, int& R, int& C) { const int st = b / 1024, sb = b % 1024, swz = sb ^ (((sb >> 9) & 1) << 5); R = (st >> 1) * 16 + swz / 64; C = (st & 1) * 32 + (swz % 64) / 2; }
__host__ __device__ __forceinline__ int perm32(int rho) { const int n = rho >> 4, i = rho & 15; return 8 * (i >> 2) + 4 * n + (i & 3); }

struct Unit { int pm, pn; };
struct Gemm { const bf16_t* A; const bf16_t* Bt; int M, N, K; };

struct StaticOrder {
    int nM, nN, nwg, G, c;
    __host__ __device__ void init(int M, int N, int G_, int c_) { nM = M / BM; nN = N / BM; nwg = nM * nN; G = G_; c = c_; }
    __host__ __device__ bool next(int i, Unit& u) const {
        const long L = (long)i * G + c; if (L >= nwg) return false;
        int wgid = (int)L; { const int q = nwg / NXCD, r = nwg % NXCD, xcd = wgid % NXCD, off = wgid / NXCD; wgid = (xcd < r ? xcd * (q + 1) : r * (q + 1) + (xcd - r) * q) + off; }
        const int wgm = (nN > 16) ? 8 : 4;
        const int nig = wgm * nN, gid = wgid / nig, fm = gid * wgm, gsz = (nM - fm) < wgm ? (nM - fm) : wgm;
        u.pm = fm + ((wgid % nig) % gsz); u.pn = (wgid % nig) / gsz; return true;
    }
    __device__ __forceinline__ void a_ready(const Unit&) const {}
    __device__ __forceinline__ void done(const Unit&) const {}
};

__device__ __forceinline__ unsigned cvt_pk_bf16(float lo, float hi) { unsigned r; asm volatile("v_cvt_pk_bf16_f32 %0, %1, %2" : "=v"(r) : "v"(lo), "v"(hi)); return r; }
__device__ __forceinline__ float sigm(float x) { return 1.f / (1.f + __expf(-x)); }
struct EpiBf16S {
    static constexpr bool PERM = true, AFTER_DRAIN = false;
    bf16_t* O; int ldc;
    __device__ __forceinline__ void operator()(const f32x4 (&acc)[2][2][4][2], const Unit& u, int wr, int wc, int fr, int fq) const {
        const int row0 = u.pm * BM + wr * 64 + fr, col0 = u.pn * BM + wc * 32 + 8 * fq;
#pragma unroll
        for (int ai = 0; ai < 2; ++ai)
#pragma unroll
            for (int m = 0; m < 4; ++m) { bf16_t* rowp = O + (size_t)(row0 + ai * HALF + m * 16) * ldc + col0;
#pragma unroll
                for (int bj = 0; bj < 2; ++bj) { const f32x4 v0 = acc[ai][bj][m][0], v1 = acc[ai][bj][m][1];
                    u32x4 w; w.x = cvt_pk_bf16(v0[0], v0[1]); w.y = cvt_pk_bf16(v0[2], v0[3]); w.z = cvt_pk_bf16(v1[0], v1[1]); w.w = cvt_pk_bf16(v1[2], v1[3]);
                    *(u32x4*)(rowp + bj * HALF) = w; } }
    }
};
struct EpiResid {
    static constexpr bool PERM = true, AFTER_DRAIN = false;
    const float* R; const bf16_t* Rb; float* O; bf16_t* Ob; int ld;
    __device__ __forceinline__ void operator()(const f32x4 (&acc)[2][2][4][2], const Unit& u, int wr, int wc, int fr, int fq) const {
        const int row0 = u.pm * BM + wr * 64 + fr, col0 = u.pn * BM + wc * 32 + 8 * fq;
#pragma unroll
        for (int ai = 0; ai < 2; ++ai)
#pragma unroll
            for (int m = 0; m < 4; ++m) { const size_t ro = (size_t)(row0 + ai * HALF + m * 16) * ld + col0;
#pragma unroll
                for (int bj = 0; bj < 2; ++bj) { const size_t off = ro + bj * HALF;
                    f32x4 r0, r1;
                    if (Rb) { const u32x4 rb = *(const u32x4*)(Rb + off);
                        r0 = (f32x4){__uint_as_float(rb.x << 16), __uint_as_float(rb.x & 0xffff0000u), __uint_as_float(rb.y << 16), __uint_as_float(rb.y & 0xffff0000u)};
                        r1 = (f32x4){__uint_as_float(rb.z << 16), __uint_as_float(rb.z & 0xffff0000u), __uint_as_float(rb.w << 16), __uint_as_float(rb.w & 0xffff0000u)}; }
                    else { r0 = *(const f32x4*)(R + off); r1 = *(const f32x4*)(R + off + 4); }
                    const f32x4 v0 = r0 + acc[ai][bj][m][0], v1 = r1 + acc[ai][bj][m][1];
                    if (Ob) { u32x4 w; w.x = cvt_pk_bf16(v0[0], v0[1]); w.y = cvt_pk_bf16(v0[2], v0[3]); w.z = cvt_pk_bf16(v1[0], v1[1]); w.w = cvt_pk_bf16(v1[2], v1[3]); *(u32x4*)(Ob + off) = w; }
                    else { *(f32x4*)(O + off) = v0; *(f32x4*)(O + off + 4) = v1; } } }
    }
};
template <int CTRL> __device__ __forceinline__ float dpp_mov(float v) { return __builtin_bit_cast(float, __builtin_amdgcn_update_dpp(0, __builtin_bit_cast(int, v), CTRL, 0xf, 0xf, false)); }
struct EpiGLU {
    static constexpr bool PERM = true, AFTER_DRAIN = false;
    bf16_t* ACT; bf16_t* Praw; const float* cw; const float* cb; PG8_LAS float* xch;
    __device__ __forceinline__ void operator()(const f32x4 (&acc)[2][2][4][2], const Unit& u, int wr, int wc, int fr, int fq) const {
        const int colg = wc * 32 + 8 * fq, j0 = u.pn * 128 + colg;
        if (fr >= 14) {
#pragma unroll
            for (int ai = 0; ai < 2; ++ai)
#pragma unroll
                for (int n = 0; n < 2; ++n) *(PG8_LAS f32x4*)(xch + (((ai * 2 + wr) * 2 + (fr - 14)) * 128 + colg + 4 * n)) = acc[ai][0][3][n];
        }
        asm volatile("s_waitcnt lgkmcnt(0)" ::: "memory"); __builtin_amdgcn_s_barrier(); asm volatile("" ::: "memory");
        f32x4 w0[2], w1[2], w2[2], bs[2];
#pragma unroll
        for (int n = 0; n < 2; ++n) { w0[n] = *(const f32x4*)(cw + j0 + 4 * n); w1[n] = *(const f32x4*)(cw + 5632 + j0 + 4 * n); w2[n] = *(const f32x4*)(cw + 2 * 5632 + j0 + 4 * n); bs[n] = *(const f32x4*)(cb + j0 + 4 * n); }
#pragma unroll
        for (int ai = 0; ai < 2; ++ai) {
            const int chunk = ai * 2 + wr;
            f32x4 a1[2], a2[2];
#pragma unroll
            for (int n = 0; n < 2; ++n) { a1[n] = (f32x4){0.f, 0.f, 0.f, 0.f}; a2[n] = a1[n]; }
            if (chunk > 0) {
#pragma unroll
                for (int n = 0; n < 2; ++n) { a1[n] = *(const PG8_LAS f32x4*)(xch + (((chunk - 1) * 2 + 1) * 128 + colg + 4 * n)); a2[n] = *(const PG8_LAS f32x4*)(xch + (((chunk - 1) * 2 + 0) * 128 + colg + 4 * n)); }
            }
#pragma unroll
            for (int m = 0; m < 4; ++m) {
                const int row = u.pm * BM + ai * HALF + wr * 64 + m * 16 + fr;
                float o[8];
#pragma unroll
                for (int n = 0; n < 2; ++n)
#pragma unroll
                    for (int e = 0; e < 4; ++e) {
                        const float g0 = acc[ai][0][m][n][e];
                        const float r1 = dpp_mov<0x121>(g0), r2 = dpp_mov<0x122>(g0);
                        float p1, p2;
                        if (m > 0) { const float gp = acc[ai][0][m > 0 ? m - 1 : 0][n][e]; p1 = dpp_mov<0x121>(gp); p2 = dpp_mov<0x122>(gp); }
                        else { p1 = a1[n][e]; p2 = (fr == 1) ? a1[n][e] : a2[n][e]; }
                        const float g1 = (fr >= 1) ? r1 : p1, g2 = (fr >= 2) ? r2 : p2;
                        const float cv = w0[n][e] * g2 + w1[n][e] * g1 + w2[n][e] * g0 + bs[n][e];
                        o[4 * n + e] = cv / (1.f + __expf(-cv)) * acc[ai][1][m][n][e];
                    }
                u32x4 w; w.x = cvt_pk_bf16(o[0], o[1]); w.y = cvt_pk_bf16(o[2], o[3]); w.z = cvt_pk_bf16(o[4], o[5]); w.w = cvt_pk_bf16(o[6], o[7]);
                *(u32x4*)(ACT + (size_t)row * 5632 + j0) = w;
                if ((chunk == 0 && m == 0 && fr < 2) || (chunk == 3 && m == 3 && fr >= 14)) {
                    const f32x4 gA = acc[ai][0][m][0], gB = acc[ai][0][m][1], uA = acc[ai][1][m][0], uB = acc[ai][1][m][1];
                    u32x4 wg, wu; wg.x = cvt_pk_bf16(gA[0], gA[1]); wg.y = cvt_pk_bf16(gA[2], gA[3]); wg.z = cvt_pk_bf16(gB[0], gB[1]); wg.w = cvt_pk_bf16(gB[2], gB[3]);
                    wu.x = cvt_pk_bf16(uA[0], uA[1]); wu.y = cvt_pk_bf16(uA[2], uA[3]); wu.z = cvt_pk_bf16(uB[0], uB[1]); wu.w = cvt_pk_bf16(uB[2], uB[3]);
                    const size_t ro = (size_t)(u.pm * 4 + (chunk == 0 ? fr : fr - 12)) * 11264;
                    *(u32x4*)(Praw + ro + j0) = wg; *(u32x4*)(Praw + ro + 5632 + j0) = wu;
                }
            }
        }
    }
};
struct EpiProj {
    static constexpr bool PERM = true, AFTER_DRAIN = false;
    bf16_t* O; int ldc; const float* qgain; const float* kgain; float* KM; PG8_LAS float* xs; float qpost, eps;
    __device__ __forceinline__ void operator()(const f32x4 (&acc)[2][2][4][2], const Unit& u, int wr, int wc, int fr, int fq) const {
        const int row0 = u.pm * BM + wr * 64 + fr, col0 = u.pn * BM + wc * 32 + 8 * fq;
        if (u.pn >= 8) {
#pragma unroll
            for (int ai = 0; ai < 2; ++ai)
#pragma unroll
                for (int m = 0; m < 4; ++m) { bf16_t* rowp = O + (size_t)(row0 + ai * HALF + m * 16) * ldc + col0;
#pragma unroll
                    for (int bj = 0; bj < 2; ++bj) { const f32x4 v0 = acc[ai][bj][m][0], v1 = acc[ai][bj][m][1];
                        u32x4 w; w.x = cvt_pk_bf16(v0[0], v0[1]); w.y = cvt_pk_bf16(v0[2], v0[3]); w.z = cvt_pk_bf16(v1[0], v1[1]); w.w = cvt_pk_bf16(v1[2], v1[3]);
                        *(u32x4*)(rowp + bj * HALF) = w; } }
            return;
        }
        const bool isk = u.pn >= 4;
#pragma unroll
        for (int ai = 0; ai < 2; ++ai)
#pragma unroll
            for (int m = 0; m < 4; ++m)
#pragma unroll
                for (int bj = 0; bj < 2; ++bj) { const f32x4 a0 = acc[ai][bj][m][0], a1 = acc[ai][bj][m][1];
                    float sq = (a0[0] * a0[0] + a0[1] * a0[1]) + (a0[2] * a0[2] + a0[3] * a0[3]) + (a1[0] * a1[0] + a1[1] * a1[1]) + (a1[2] * a1[2] + a1[3] * a1[3]);
                    sq += __shfl_xor(sq, 16); sq += __shfl_xor(sq, 32);
                    if (fq == 0) xs[((((ai * 2 + wr) * 2 + bj) * 4 + m) * 16 + fr) * 4 + wc] = sq; }
        asm volatile("s_waitcnt lgkmcnt(0)" ::: "memory"); __builtin_amdgcn_s_barrier(); asm volatile("" ::: "memory");
        const float* gain = (isk ? kgain : qgain) + wc * 32 + 8 * fq;
        const f32x4 g0 = *(const f32x4*)gain, g1 = *(const f32x4*)(gain + 4);
        const float post = isk ? 1.f : qpost;
        PG8_LAS float* ks = xs + 2048;
#pragma unroll
        for (int bj = 0; bj < 2; ++bj) {
            int rq = row0; asm volatile("" : "+v"(rq));
            f32x4 c0 = (f32x4){0.f, 0.f, 0.f, 0.f}, c1 = c0;
#pragma unroll
            for (int ai = 0; ai < 2; ++ai)
#pragma unroll
                for (int m = 0; m < 4; ++m) { bf16_t* rowp = O + (size_t)(rq + ai * HALF + m * 16) * ldc + col0 + bj * HALF;
                    const f32x4 t = *(const PG8_LAS f32x4*)(xs + ((((ai * 2 + wr) * 2 + bj) * 4 + m) * 16 + fr) * 4);
                    const float rinv = rsqrtf(((t[0] + t[1]) + (t[2] + t[3])) * (1.f / 128) + eps) * post;
                    const f32x4 v0 = acc[ai][bj][m][0] * rinv * g0, v1 = acc[ai][bj][m][1] * rinv * g1;
                    c0 += v0; c1 += v1;
                    u32x4 w; w.x = cvt_pk_bf16(v0[0], v0[1]); w.y = cvt_pk_bf16(v0[2], v0[3]); w.z = cvt_pk_bf16(v1[0], v1[1]); w.w = cvt_pk_bf16(v1[2], v1[3]);
                    *(u32x4*)rowp = w; }
            if (isk) {
#pragma unroll
                for (int e = 0; e < 4; ++e) { float v = c0[e]; v += dpp_mov<0xB1>(v); v += dpp_mov<0x4E>(v); v += dpp_mov<0x141>(v); v += dpp_mov<0x140>(v); c0[e] = v;
                    float x = c1[e]; x += dpp_mov<0xB1>(x); x += dpp_mov<0x4E>(x); x += dpp_mov<0x141>(x); x += dpp_mov<0x140>(x); c1[e] = x; }
                if (fr == 0) { *(PG8_LAS f32x4*)(ks + (((wr * 2 + bj) * 4 + wc) * 4 + fq) * 8) = c0; *(PG8_LAS f32x4*)(ks + (((wr * 2 + bj) * 4 + wc) * 4 + fq) * 8 + 4) = c1; }
            }
        }
        if (isk) {
            asm volatile("s_waitcnt lgkmcnt(0)" ::: "memory"); __builtin_amdgcn_s_barrier(); asm volatile("" ::: "memory");
            if (wr == 0 && fr == 0) {
                const int b = u.pm >> 4, nb = u.pm & 15;
#pragma unroll
                for (int bj = 0; bj < 2; ++bj) { const int h = 2 * (u.pn - 4) + bj;
                    float* kmp = KM + ((size_t)(b * 8 + h) * 16 + nb) * 128 + wc * 32 + 8 * fq;
#pragma unroll
                    for (int n = 0; n < 2; ++n) { const f32x4 x0 = *(const PG8_LAS f32x4*)(ks + (((0 * 2 + bj) * 4 + wc) * 4 + fq) * 8 + n * 4), x1 = *(const PG8_LAS f32x4*)(ks + (((1 * 2 + bj) * 4 + wc) * 4 + fq) * 8 + n * 4);
                        *(f32x4*)(kmp + 4 * n) = (x0 + x1) * (1.f / 256); } }
            }
        }
    }
};
struct EpiGate {
    static constexpr bool PERM = true, AFTER_DRAIN = false;
    bf16_t* O; int ldo; const bf16_t* Gt; int ldg; int accum;
    __device__ __forceinline__ void operator()(const f32x4 (&acc)[2][2][4][2], const Unit& u, int wr, int wc, int fr, int fq) const {
        const int row0 = u.pm * BM + wr * 64 + fr, col0 = u.pn * BM + wc * 32 + 8 * fq;
#pragma unroll
        for (int ai = 0; ai < 2; ++ai)
#pragma unroll
            for (int m = 0; m < 4; ++m) { const size_t r = (size_t)(row0 + ai * HALF + m * 16);
#pragma unroll
                for (int bj = 0; bj < 2; ++bj) { const int c = col0 + bj * HALF;
                    const u32x4 gt = *(const u32x4*)(Gt + r * ldg + c);
                    const f32x4 a0 = acc[ai][bj][m][0], a1 = acc[ai][bj][m][1];
                    float v[8];
                    v[0] = a0[0] * sigm(__uint_as_float(gt.x << 16)); v[1] = a0[1] * sigm(__uint_as_float(gt.x & 0xffff0000u));
                    v[2] = a0[2] * sigm(__uint_as_float(gt.y << 16)); v[3] = a0[3] * sigm(__uint_as_float(gt.y & 0xffff0000u));
                    v[4] = a1[0] * sigm(__uint_as_float(gt.z << 16)); v[5] = a1[1] * sigm(__uint_as_float(gt.z & 0xffff0000u));
                    v[6] = a1[2] * sigm(__uint_as_float(gt.w << 16)); v[7] = a1[3] * sigm(__uint_as_float(gt.w & 0xffff0000u));
                    bf16_t* op = O + r * ldo + c;
                    if (accum) { const u32x4 pv = *(const u32x4*)op;
                        v[0] += __uint_as_float(pv.x << 16); v[1] += __uint_as_float(pv.x & 0xffff0000u);
                        v[2] += __uint_as_float(pv.y << 16); v[3] += __uint_as_float(pv.y & 0xffff0000u);
                        v[4] += __uint_as_float(pv.z << 16); v[5] += __uint_as_float(pv.z & 0xffff0000u);
                        v[6] += __uint_as_float(pv.w << 16); v[7] += __uint_as_float(pv.w & 0xffff0000u); }
                    u32x4 w; w.x = cvt_pk_bf16(v[0], v[1]); w.y = cvt_pk_bf16(v[2], v[3]); w.z = cvt_pk_bf16(v[4], v[5]); w.w = cvt_pk_bf16(v[6], v[7]);
                    *(u32x4*)op = w; } }
    }
};
template <class Epi, class Sched, bool ALIGN_EPI = false, bool SP2 = false>
__device__ __forceinline__ void gemm_phase(PG8_LAS unsigned char* lds, const Gemm g, const Sched& S, const Epi& E) {
    int tid = threadIdx.x; asm volatile("" : "+v"(tid));
    const int wid = __builtin_amdgcn_readfirstlane(tid >> 6), lane = tid & 63, wr = wid >> 2, wc = wid & 3, fr = lane & 15, fq = lane >> 4;
    const int K = g.K, nt = K / BK;
    unsigned voffA[2], voffB[2];
#pragma unroll
    for (int i = 0; i < 2; ++i) { int R, C; stage_rc(tid * 16 + i * 8192, R, C); const int Rb = Epi::PERM ? ((R & ~31) + perm32(R & 31)) : R;
        voffA[i] = (unsigned)(R * K + C) * 2u; voffB[i] = (unsigned)(Rb * K + C) * 2u; }
    const size_t kstep = (size_t)(BK * 2);
    const size_t hstep = (size_t)HALF * K * 2;
    const size_t tstep = 2 * hstep;
    const unsigned ldsw = (unsigned)wid * 1024u;
    const int aoff = lds_byte(wr * 64 + fr, fq * 8), boff = lds_byte(wc * 32 + fr, fq * 8);
#define PG8_SA(b, h) (((b) * 2 + (h)) * HTB)
#define PG8_SB(b, h) ((4 + (b) * 2 + (h)) * HTB)
#define PG8_STAGE(bufoff, gbase, voff) do { _Pragma("unroll") for (int _i = 0; _i < 2; ++_i) \
        __builtin_amdgcn_global_load_lds((const unsigned*)((const char*)(gbase) + (voff)[_i]), (PG8_LAS unsigned*)(lds + (bufoff) + ldsw + _i * 8192), 16, 0, 0); } while (0)
#define PG8_LDA(dst, b, h) do { _Pragma("unroll") for (int m = 0; m < 4; ++m) _Pragma("unroll") for (int k = 0; k < 2; ++k) dst[m][k] = *(const PG8_LAS bf16x8*)(lds + PG8_SA(b, h) + aoff + m * 2048 + k * 1024); } while (0)
#define PG8_LDB(dst, b, h) do { _Pragma("unroll") for (int n = 0; n < 2; ++n) _Pragma("unroll") for (int k = 0; k < 2; ++k) dst[n][k] = *(const PG8_LAS bf16x8*)(lds + PG8_SB(b, h) + boff + n * 2048 + k * 1024); } while (0)
#define PG8_MMA(ai, bj, At, Bt) do { __builtin_amdgcn_s_setprio(1); _Pragma("unroll") for (int m = 0; m < 4; ++m) _Pragma("unroll") for (int n = 0; n < 2; ++n) _Pragma("unroll") for (int k = 0; k < 2; ++k) \
        acc[ai][bj][m][n] = __builtin_amdgcn_mfma_f32_16x16x32_bf16(Bt[n][k], At[m][k], acc[ai][bj][m][n], 0, 0, 0); __builtin_amdgcn_s_setprio(0); } while (0)
#define PG8_WAIT_V(n) asm volatile("s_waitcnt vmcnt(" #n ")" ::: "memory")
#define PG8_WAIT_L(n) asm volatile("s_waitcnt lgkmcnt(" #n ")" ::: "memory")
#define PG8_BAR __builtin_amdgcn_s_barrier()
#define PG8_SCHED __builtin_amdgcn_sched_barrier(0)
    Unit cur, nxt; int ui = 0;
    if (!S.next(0, cur)) return;
    f32x4 acc[2][2][4][2];
#pragma unroll
    for (int a = 0; a < 2; ++a)
#pragma unroll
        for (int b = 0; b < 2; ++b)
#pragma unroll
            for (int m = 0; m < 4; ++m)
#pragma unroll
                for (int n = 0; n < 2; ++n) acc[a][b][m][n] = (f32x4){0.f, 0.f, 0.f, 0.f};
    bf16x8 At[4][2], B0[2][2], B1[2][2];
    const char* cA = (const char*)g.A + (size_t)cur.pm * tstep; const char* cB = (const char*)g.Bt + (size_t)cur.pn * tstep;
    S.a_ready(cur);
    if constexpr (SP2) {
        PG8_STAGE(PG8_SB(0, 0), cB, voffB); PG8_STAGE(PG8_SB(0, 1), cB + hstep, voffB); PG8_STAGE(PG8_SA(0, 0), cA, voffA); PG8_STAGE(PG8_SA(0, 1), cA + hstep, voffA);
        if (wr == 1) PG8_BAR;
        PG8_WAIT_V(2); PG8_BAR;
        PG8_STAGE(PG8_SB(1, 0), cB + kstep, voffB); PG8_STAGE(PG8_SA(1, 0), cA + kstep, voffA); PG8_STAGE(PG8_SB(1, 1), cB + hstep + kstep, voffB);
        PG8_WAIT_V(6); PG8_BAR;
    } else {
        PG8_STAGE(PG8_SB(0, 0), cB, voffB); PG8_STAGE(PG8_SA(0, 0), cA, voffA); PG8_STAGE(PG8_SB(0, 1), cB + hstep, voffB); PG8_STAGE(PG8_SA(0, 1), cA + hstep, voffA);
        if (wr == 1) PG8_BAR;
        PG8_WAIT_V(4); PG8_BAR;
        PG8_STAGE(PG8_SB(1, 0), cB + kstep, voffB); PG8_STAGE(PG8_SA(1, 0), cA + kstep, voffA); PG8_STAGE(PG8_SB(1, 1), cB + hstep + kstep, voffB);
        PG8_WAIT_V(6); PG8_BAR;
    }
    for (;;) {
        const bool has_next = S.next(ui + 1, nxt);
        const char* nA = has_next ? (const char*)g.A + (size_t)nxt.pm * tstep : cA; const char* nB = has_next ? (const char*)g.Bt + (size_t)nxt.pn * tstep : cB;
        for (int t = 0; t < nt; t += 2) {
            const bool last = (t == nt - 2);
            const char* a1 = cA + (size_t)(t + 1) * kstep;
            const char* a2 = last ? nA : cA + (size_t)(t + 2) * kstep; const char* b2 = last ? nB : cB + (size_t)(t + 2) * kstep;
            const char* a3 = a2 + kstep; const char* b3 = b2 + kstep;
            if (last && has_next) S.a_ready(nxt);
            if constexpr (SP2) {
            PG8_LDB(B0, 0, 0); PG8_LDB(B1, 0, 1); PG8_SCHED; PG8_LDA(At, 0, 0); PG8_STAGE(PG8_SA(1, 1), a1 + hstep, voffA);
            PG8_WAIT_V(8); PG8_WAIT_L(0); PG8_BAR; PG8_MMA(0, 0, At, B0); PG8_MMA(0, 1, At, B1); PG8_BAR; PG8_SCHED;
            PG8_LDA(At, 0, 1); PG8_STAGE(PG8_SB(0, 0), b2, voffB); PG8_STAGE(PG8_SB(0, 1), b2 + hstep, voffB); PG8_STAGE(PG8_SA(0, 0), a2, voffA);
            PG8_WAIT_V(8); PG8_WAIT_L(0); PG8_BAR; PG8_MMA(1, 0, At, B0); PG8_MMA(1, 1, At, B1); PG8_BAR; PG8_SCHED;
            PG8_LDB(B0, 1, 0); PG8_LDB(B1, 1, 1); PG8_SCHED; PG8_LDA(At, 1, 0); PG8_STAGE(PG8_SA(0, 1), a2 + hstep, voffA);
            PG8_WAIT_V(8); PG8_WAIT_L(0); PG8_BAR; PG8_MMA(0, 0, At, B0); PG8_MMA(0, 1, At, B1); PG8_BAR; PG8_SCHED;
            PG8_LDA(At, 1, 1); PG8_STAGE(PG8_SB(1, 0), b3, voffB); PG8_STAGE(PG8_SB(1, 1), b3 + hstep, voffB); PG8_STAGE(PG8_SA(1, 0), a3, voffA);
            PG8_WAIT_V(8); PG8_WAIT_L(0); PG8_BAR; PG8_MMA(1, 0, At, B0); PG8_MMA(1, 1, At, B1); PG8_BAR; PG8_SCHED;
            } else {
            PG8_LDB(B0, 0, 0); PG8_SCHED; PG8_LDA(At, 0, 0); PG8_STAGE(PG8_SA(1, 1), a1 + hstep, voffA);
            PG8_WAIT_L(8); PG8_BAR; PG8_WAIT_L(0); PG8_MMA(0, 0, At, B0); PG8_BAR; PG8_SCHED;
            PG8_LDB(B1, 0, 1); PG8_STAGE(PG8_SB(0, 0), b2, voffB);
            PG8_BAR; PG8_WAIT_L(0); PG8_MMA(0, 1, At, B1); PG8_BAR;
            PG8_LDA(At, 0, 1); PG8_STAGE(PG8_SA(0, 0), a2, voffA);
            PG8_BAR; PG8_WAIT_L(0); PG8_MMA(1, 0, At, B0); PG8_BAR; PG8_SCHED;
            PG8_STAGE(PG8_SB(0, 1), b2 + hstep, voffB);
            PG8_WAIT_V(6); PG8_BAR; PG8_MMA(1, 1, At, B1); PG8_BAR;
            PG8_LDB(B0, 1, 0); PG8_SCHED; PG8_LDA(At, 1, 0); PG8_STAGE(PG8_SA(0, 1), a2 + hstep, voffA);
            PG8_WAIT_L(8); PG8_BAR; PG8_WAIT_L(0); PG8_MMA(0, 0, At, B0); PG8_BAR; PG8_SCHED;
            PG8_LDB(B1, 1, 1); PG8_STAGE(PG8_SB(1, 0), b3, voffB);
            PG8_BAR; PG8_WAIT_L(0); PG8_MMA(0, 1, At, B1); PG8_BAR;
            PG8_LDA(At, 1, 1); PG8_STAGE(PG8_SA(1, 0), a3, voffA);
            PG8_BAR; PG8_WAIT_L(0); PG8_MMA(1, 0, At, B0); PG8_BAR; PG8_SCHED;
            PG8_STAGE(PG8_SB(1, 1), b3 + hstep, voffB);
            PG8_WAIT_V(6); PG8_BAR; PG8_MMA(1, 1, At, B1); PG8_BAR;
            }
        }
        if constexpr (ALIGN_EPI) { if (wr == 0) PG8_BAR; }
        if constexpr (!Epi::AFTER_DRAIN) { E(acc, cur, wr, wc, fr, fq); S.done(cur); }
        if (!has_next) break;
#pragma unroll
        for (int a = 0; a < 2; ++a)
#pragma unroll
            for (int b = 0; b < 2; ++b)
#pragma unroll
                for (int m = 0; m < 4; ++m)
#pragma unroll
                    for (int n = 0; n < 2; ++n) acc[a][b][m][n] = (f32x4){0.f, 0.f, 0.f, 0.f};
        cur = nxt; cA = nA; cB = nB; ++ui;
        if constexpr (ALIGN_EPI) { if (wr == 1) PG8_BAR; }
    }
    PG8_WAIT_V(0);
    if constexpr (!ALIGN_EPI) { if (wr == 0) PG8_BAR; }
    PG8_BAR;
    if constexpr (Epi::AFTER_DRAIN) { E.fused(acc, cur, wr, wc, fr, fq, lds, wid, lane); S.done(cur); }
#undef PG8_SA
#undef PG8_SB
#undef PG8_STAGE
#undef PG8_LDA
#undef PG8_LDB
#undef PG8_MMA
#undef PG8_WAIT_V
#undef PG8_WAIT_L
#undef PG8_BAR
#undef PG8_SCHED
}
}

#define LAS __attribute__((address_space(3)))
typedef unsigned short bf16;
typedef unsigned v4u __attribute__((ext_vector_type(4)));
typedef float f32x4 __attribute__((ext_vector_type(4)));
typedef float f32x2 __attribute__((ext_vector_type(2)));
typedef float f32x16 __attribute__((ext_vector_type(16)));
typedef short bf16x8 __attribute__((ext_vector_type(8)));

constexpr int TT = 16384, DM = 2048, SEQ = 4096, NH = 8;
constexpr int INC = 11280;
constexpr int NP = 11264;
constexpr int DFF = 5632;
constexpr int C_MK = 1024, C_MV = 2048, C_DQ = 3072, C_DZ = 6144, C_GA = 7168, C_GB = 9216;
constexpr float EPS = 1e-6f;
constexpr float QSCALE = 0.08838834764831845f;
constexpr float QSCALE_L2E = 0.08838834764831845f * 1.4426950408889634f;

constexpr size_t MiB = 1u << 20;
constexpr size_t WS_W = 1 * MiB, WS_P = 128 * MiB, WS_R = 480 * MiB, WS_BG = 672 * MiB, WS_KM = 673 * MiB, WS_END = 674 * MiB;
constexpr size_t W_IN = 0, W_A = 23068672, W_B = 25165824, W_O = 27262976, W_FI = 31457280, W_FD = 54525952, W_BA = 66060288;
constexpr size_t R_H = 0, R_YA = 64 * MiB, R_YB = 96 * MiB, R_MG = 128 * MiB, R_ACT = 0, R_DQ = 0, R_DK = 32 * MiB, R_DV = 128 * MiB, R_TB = 160 * MiB, R_AB = 176 * MiB;

constexpr int NPH = 11;
constexpr int LDS_BYTES = 147456;

__device__ __forceinline__ unsigned f2bf(float f) { unsigned u = __builtin_bit_cast(unsigned, f); return (u + 0x7fffu + ((u >> 16) & 1u)) >> 16; }
__device__ __forceinline__ unsigned pk2(float lo, float hi) { return f2bf(lo) | (f2bf(hi) << 16); }
__device__ __forceinline__ float bflo(unsigned u) { return __uint_as_float(u << 16); }
__device__ __forceinline__ float bfhi(unsigned u) { return __uint_as_float(u & 0xffff0000u); }
__device__ __forceinline__ float bf1(bf16 h) { return __uint_as_float(((unsigned)h) << 16); }
__device__ __forceinline__ float wave_sum(float v) {
#pragma unroll
    for (int o = 1; o < 64; o <<= 1) v += __shfl_xor(v, o);
    return v;
}
__device__ __forceinline__ float siluf_(float x) { return x / (1.f + __expf(-x)); }
__device__ __forceinline__ int crow(int reg, int h) { return (reg & 3) + 8 * (reg >> 2) + 4 * h; }

typedef short s16x4 __attribute__((ext_vector_type(4)));
typedef short v4i16_t __attribute__((ext_vector_type(4)));
__device__ __forceinline__ s16x4 tr_read(LAS const unsigned char* p) { return __builtin_bit_cast(s16x4, __builtin_amdgcn_ds_read_tr16_b64_v4i16((LAS v4i16_t*)p)); }
__device__ __forceinline__ float bfs(short h) { return __uint_as_float(((unsigned)(unsigned short)h) << 16); }
typedef float f32x2_t __attribute__((ext_vector_type(2)));
typedef __bf16 bf16x2_t __attribute__((ext_vector_type(2)));
__device__ __forceinline__ unsigned cvtpk(float lo, float hi) { f32x2_t v = {lo, hi}; bf16x2_t b = __builtin_convertvector(v, bf16x2_t); return __builtin_bit_cast(unsigned, b); }

__device__ __forceinline__ void moba_item(LAS unsigned char* lds, const bf16* P, const float* KM, bf16* YA, int b, int h, int qb, int tid, int lane, int wave) {
    const int r = lane & 31, hh = lane >> 5;
    const size_t rowb = (size_t)b * SEQ;
    const int qin = 32 * wave + r;
    bf16x8 qf[8];
    { const bf16* qp = P + (rowb + qb * 256 + qin) * NP + h * 128 + 8 * hh;
#pragma unroll
      for (int st = 0; st < 8; ++st) qf[st] = *(const bf16x8*)(qp + 16 * st); }
    unsigned sel;
    if (qb <= 3) sel = (1u << qb) - 1u;
    else {
        float g1 = -INFINITY, g2 = -INFINITY, g3 = -INFINITY; int i1 = 0, i2 = 0, i3 = 0;
        for (int n = 0; n < qb; ++n) {
            const float* km = KM + ((size_t)(b * 8 + h) * 16 + n) * 128 + 8 * hh;
            float gs = 0.f;
#pragma unroll
            for (int st = 0; st < 8; ++st) { const f32x4 m0 = *(const f32x4*)(km + 16 * st), m1 = *(const f32x4*)(km + 16 * st + 4);
                gs += bfs(qf[st][0]) * m0.x + bfs(qf[st][1]) * m0.y + bfs(qf[st][2]) * m0.z + bfs(qf[st][3]) * m0.w
                    + bfs(qf[st][4]) * m1.x + bfs(qf[st][5]) * m1.y + bfs(qf[st][6]) * m1.z + bfs(qf[st][7]) * m1.w; }
            gs += __shfl_xor(gs, 32);
            if (gs > g1) { g3 = g2; i3 = i2; g2 = g1; i2 = i1; g1 = gs; i1 = n; }
            else if (gs > g2) { g3 = g2; i3 = i2; g2 = gs; i2 = n; }
            else if (gs > g3) { g3 = gs; i3 = n; }
        }
        sel = (1u << i1) | (1u << i2) | (1u << i3);
    }
    f32x16 o[4];
#pragma unroll
    for (int d = 0; d < 4; ++d)
#pragma unroll
        for (int i = 0; i < 16; ++i) o[d][i] = 0.f;
    float lsum = 0.f;
    const int key0 = tid >> 4, ch = tid & 15;
    const unsigned soff = (unsigned)(key0 * 256 + ((ch ^ (key0 & 15)) << 4));
    const bf16* gk = P + (rowb + key0) * NP + C_MK + h * 128 + 8 * ch;
    const int nt = 4 * qb + 4;
    v4u kr0, kr1, vr0, vr1;
    kr0 = *(const v4u*)gk; kr1 = *(const v4u*)(gk + (size_t)32 * NP); vr0 = *(const v4u*)(gk + 1024); vr1 = *(const v4u*)(gk + (size_t)32 * NP + 1024);
    *(LAS v4u*)(lds + soff) = kr0; *(LAS v4u*)(lds + soff + 8192) = kr1; *(LAS v4u*)(lds + 32768 + soff) = vr0; *(LAS v4u*)(lds + 32768 + soff + 8192) = vr1;
    __syncthreads();
    const unsigned kbase = (unsigned)(r * 256);
    const int q4 = (lane & 15) >> 2, p4 = lane & 3, grp = (lane >> 4) & 1;
    for (int t = 0; t < nt; ++t) {
        const int n = t >> 2, tt = t & 3; const bool own = (n == qb);
        const unsigned buf = (unsigned)(t & 1) * 16384u;
        if (t + 1 < nt) { const bf16* g2p = gk + (size_t)(t + 1) * 64 * NP;
            kr0 = *(const v4u*)g2p; kr1 = *(const v4u*)(g2p + (size_t)32 * NP); vr0 = *(const v4u*)(g2p + 1024); vr1 = *(const v4u*)(g2p + (size_t)32 * NP + 1024); }
        const bool mine = (sel >> n) & 1u;
        const bool active = own ? (64 * tt <= 32 * wave + 31) : (__ballot(mine) != 0ull);
        if (active) {
            f32x16 sT[2];
#pragma unroll
            for (int kt = 0; kt < 2; ++kt) {
#pragma unroll
                for (int i = 0; i < 16; ++i) sT[kt][i] = 0.f;
#pragma unroll
                for (int st = 0; st < 8; ++st) {
                    const bf16x8 kf = *(const LAS bf16x8*)(lds + buf + kbase + kt * 8192 + (((2 * st + hh) ^ (r & 15)) << 4));
                    sT[kt] = __builtin_amdgcn_mfma_f32_32x32x16_bf16(kf, qf[st], sT[kt], 0, 0, 0);
                }
            }
            bf16x8 pf[2][2];
#pragma unroll
            for (int kt = 0; kt < 2; ++kt) {
#pragma unroll
                for (int i = 0; i < 16; ++i) {
                    const int key = 64 * tt + 32 * kt + crow(i, hh);
                    const bool ok = own ? (key <= qin) : mine;
                    const float pv = ok ? __builtin_amdgcn_exp2f(sT[kt][i]) : 0.f;
                    lsum += pv; sT[kt][i] = pv;
                }
#pragma unroll
                for (int s = 0; s < 2; ++s) { v4u w; w.x = cvtpk(sT[kt][8 * s], sT[kt][8 * s + 1]); w.y = cvtpk(sT[kt][8 * s + 2], sT[kt][8 * s + 3]);
                    w.z = cvtpk(sT[kt][8 * s + 4], sT[kt][8 * s + 5]); w.w = cvtpk(sT[kt][8 * s + 6], sT[kt][8 * s + 7]); pf[kt][s] = __builtin_bit_cast(bf16x8, w); }
            }
#pragma unroll
            for (int dt = 0; dt < 4; ++dt) {
                const int chunk = 4 * dt + 2 * grp + (p4 >> 1);
#pragma unroll
                for (int kt = 0; kt < 2; ++kt)
#pragma unroll
                    for (int s = 0; s < 2; ++s) {
                        const int klo = 32 * kt + 16 * s + 4 * hh + q4, khi = klo + 8;
                        const s16x4 lo = tr_read(lds + 32768 + buf + klo * 256 + ((chunk ^ (klo & 15)) << 4) + 8 * (p4 & 1));
                        const s16x4 hi = tr_read(lds + 32768 + buf + khi * 256 + ((chunk ^ (khi & 15)) << 4) + 8 * (p4 & 1));
                        const bf16x8 vf = __builtin_shufflevector(lo, hi, 0, 1, 2, 3, 4, 5, 6, 7);
                        o[dt] = __builtin_amdgcn_mfma_f32_32x32x16_bf16(vf, pf[kt][s], o[dt], 0, 0, 0);
                    }
            }
        }
        if (t + 1 < nt) { const unsigned nb = (unsigned)((t + 1) & 1) * 16384u;
            *(LAS v4u*)(lds + nb + soff) = kr0; *(LAS v4u*)(lds + nb + soff + 8192) = kr1; *(LAS v4u*)(lds + 32768 + nb + soff) = vr0; *(LAS v4u*)(lds + 32768 + nb + soff + 8192) = vr1; }
        __syncthreads();
    }
    lsum += __shfl_xor(lsum, 32);
    const float inv = 1.f / lsum;
    bf16* yp = YA + (rowb + qb * 256 + qin) * 1024 + h * 128 + 4 * hh;
#pragma unroll
    for (int dt = 0; dt < 4; ++dt)
#pragma unroll
        for (int g = 0; g < 4; ++g) {
            unsigned long long w = (unsigned long long)cvtpk(o[dt][4 * g] * inv, o[dt][4 * g + 1] * inv) | ((unsigned long long)cvtpk(o[dt][4 * g + 2] * inv, o[dt][4 * g + 3] * inv) << 32);
            *(unsigned long long*)(yp + 32 * dt + 8 * g) = w;
        }
}

typedef unsigned v2u __attribute__((ext_vector_type(2)));
#define LBAR() do { asm volatile("s_waitcnt lgkmcnt(0)" ::: "memory"); __builtin_amdgcn_s_barrier(); asm volatile("" ::: "memory"); } while (0)
__device__ __forceinline__ int perm16(int o) { const int pc = o >> 2; return (o & 3) + 4 * ((pc == 1) ? 2 : ((pc == 2) ? 1 : pc)); }
template <int CTRL> __device__ __forceinline__ float dppf(float v) { return __builtin_bit_cast(float, __builtin_amdgcn_update_dpp(0, __builtin_bit_cast(int, v), CTRL, 0xf, 0xf, true)); }
__device__ __forceinline__ float bfe(const v4u& v, int e) { return (e & 1) ? bfhi(v[e >> 1]) : bflo(v[e >> 1]); }
__device__ __forceinline__ bf16x8 comb(v2u lo, v2u hi) { v4u w; w.x = lo.x; w.y = lo.y; w.z = hi.x; w.w = hi.y; return __builtin_bit_cast(bf16x8, w); }
__device__ __forceinline__ bf16x8 pack8(const f32x16& x, int s) { v4u w; w.x = cvtpk(x[8 * s], x[8 * s + 1]); w.y = cvtpk(x[8 * s + 2], x[8 * s + 3]); w.z = cvtpk(x[8 * s + 4], x[8 * s + 5]); w.w = cvtpk(x[8 * s + 6], x[8 * s + 7]); return __builtin_bit_cast(bf16x8, w); }

constexpr int DP_K = 4096, DP_Q = DP_K + 16384, DP_G = DP_Q + 16384, DP_B = DP_G + 256, DP_L = DP_B + 256, DP_T = DP_L + 16384, DP_A = DP_T + 8192, DP_W = DP_A + 8192;
__device__ __forceinline__ void dn_prep_phase(LAS unsigned char* lds, const bf16* P, const float* cw, bf16* DQ, bf16* DK, bf16* DV, const float* BETA, float* GG, bf16* TB, bf16* AB,
                                              int G, int tid0, int wave) {
    v4u raw[3][5]; float wpre[3]; float gpre = 0.f, bpre = 0.f;
#define DP_PREFETCH(item) do { const int b_ = (item) >> 9, h_ = ((item) >> 6) & 7, c_ = (item) & 63; const size_t rowb_ = (size_t)b_ * SEQ + c_ * 64; \
        int t_ = tid0; asm volatile("" : "+v"(t_)); const int rg_ = t_ >> 4, ch_ = t_ & 15, s0_ = c_ * 64 + 2 * rg_; \
        _Pragma("unroll") for (int x = 0; x < 3; ++x) _Pragma("unroll") for (int i = 0; i < 5; ++i) { \
            if (s0_ - 3 + i >= 0) raw[x][i] = *(const v4u*)(P + (rowb_ + 2 * rg_ + i - 3) * NP + C_DQ + x * 1024 + h_ * 128 + 8 * ch_); else raw[x][i] = (v4u){0u, 0u, 0u, 0u}; } \
        _Pragma("unroll") for (int j = 0; j < 3; ++j) { const int e = t_ + 512 * j, x = e >> 9, i = (e >> 7) & 3, d = e & 127; wpre[j] = cw[i * 3072 + x * 1024 + h_ * 128 + d]; } \
        if (wave == 0) { gpre = GG[(rowb_ + (t_ & 63)) * 8 + h_]; bpre = BETA[(rowb_ + (t_ & 63)) * 8 + h_]; } } while (0)
    int item = blockIdx.x;
    if (item < 2048) DP_PREFETCH(item);
    for (; item < 2048; item += G) {
        int tid = tid0; asm volatile("" : "+v"(tid));
        const int lane = tid & 63;
        const int b = item >> 9, h = (item >> 6) & 7, c = item & 63;
        const size_t rowb = (size_t)b * SEQ + c * 64;
#pragma unroll
        for (int j = 0; j < 3; ++j) ((LAS float*)(lds + DP_W))[tid + 512 * j] = wpre[j];
        LBAR();
        {
            const int rg = tid >> 4, ch = tid & 15;
#pragma unroll
            for (int x = 0; x < 3; ++x) {
                float a0[8], a1[8];
#pragma unroll
                for (int e = 0; e < 8; ++e) { a0[e] = 0.f; a1[e] = 0.f; }
#pragma unroll
                for (int i = 0; i < 4; ++i) { const LAS float* wp = (const LAS float*)(lds + DP_W) + (x * 4 + i) * 128 + 8 * ch; const f32x4 w0 = *(const LAS f32x4*)wp, w1 = *(const LAS f32x4*)(wp + 4);
#pragma unroll
                    for (int e = 0; e < 8; ++e) { const float wv = (e < 4) ? w0[e & 3] : w1[e & 3]; a0[e] += wv * bfe(raw[x][i], e); a1[e] += wv * bfe(raw[x][i + 1], e); } }
                float ss0 = 0.f, ss1 = 0.f;
#pragma unroll
                for (int e = 0; e < 8; ++e) { a0[e] = siluf_(a0[e]); a1[e] = siluf_(a1[e]); ss0 += a0[e] * a0[e]; ss1 += a1[e] * a1[e]; }
                if (x < 2) {
                    ss0 += dppf<0xB1>(ss0); ss1 += dppf<0xB1>(ss1); ss0 += dppf<0x4E>(ss0); ss1 += dppf<0x4E>(ss1);
                    ss0 += dppf<0x141>(ss0); ss1 += dppf<0x141>(ss1); ss0 += dppf<0x140>(ss0); ss1 += dppf<0x140>(ss1);
                    const float r0 = rsqrtf(ss0 + EPS) * (x == 0 ? QSCALE : 1.f), r1 = rsqrtf(ss1 + EPS) * (x == 0 ? QSCALE : 1.f);
#pragma unroll
                    for (int e = 0; e < 8; ++e) { a0[e] *= r0; a1[e] *= r1; }
                }
                v4u o0, o1;
                o0.x = cvtpk(a0[0], a0[1]); o0.y = cvtpk(a0[2], a0[3]); o0.z = cvtpk(a0[4], a0[5]); o0.w = cvtpk(a0[6], a0[7]);
                o1.x = cvtpk(a1[0], a1[1]); o1.y = cvtpk(a1[2], a1[3]); o1.z = cvtpk(a1[4], a1[5]); o1.w = cvtpk(a1[6], a1[7]);
                bf16* dst = (x == 0 ? DQ : (x == 1 ? DK : DV)) + (rowb + 2 * rg) * 1024 + h * 128 + 8 * ch;
                *(v4u*)dst = o0; *(v4u*)(dst + 1024) = o1;
                if (x < 2) { LAS unsigned char* base = lds + (x == 0 ? DP_Q : DP_K); const int row = 2 * rg;
                    *(LAS v4u*)(base + row * 256 + ((ch ^ (row & 15)) << 4)) = o0; *(LAS v4u*)(base + (row + 1) * 256 + ((ch ^ ((row + 1) & 15)) << 4)) = o1; }
            }
        }
        if (wave == 0) {
            float g = gpre;
#pragma unroll
            for (int d = 1; d < 64; d <<= 1) { const float v = __shfl_up(g, d); if (lane >= d) g += v; }
            GG[(rowb + lane) * 8 + h] = g; ((LAS float*)(lds + DP_G))[lane] = g; ((LAS float*)(lds + DP_B))[lane] = bpre;
        }
        if (item + G < 2048) DP_PREFETCH(item + G);
        LBAR();
        {
            const int r = lane & 31, hh = lane >> 5;
            const LAS float* Gs = (const LAS float*)(lds + DP_G); const LAS float* Bs = (const LAS float*)(lds + DP_B);
            LAS float* Ls = (LAS float*)(lds + DP_L); LAS bf16* As = (LAS bf16*)(lds + DP_A);
            if (wave < 6) {
                const int prod = wave / 3, tl = wave % 3, ti = (tl >= 1) ? 1 : 0, tj = (tl == 2) ? 1 : 0;
                const LAS unsigned char* Ab = lds + (prod == 0 ? DP_K : DP_Q) + (32 * ti + r) * 256; const LAS unsigned char* Bb = lds + DP_K + (32 * tj + r) * 256;
                f32x16 acc;
#pragma unroll
                for (int i = 0; i < 16; ++i) acc[i] = 0.f;
#pragma unroll
                for (int st = 0; st < 8; ++st) { const int sw = ((2 * st + hh) ^ (r & 15)) << 4;
                    acc = __builtin_amdgcn_mfma_f32_32x32x16_bf16(*(const LAS bf16x8*)(Ab + sw), *(const LAS bf16x8*)(Bb + sw), acc, 0, 0, 0); }
                const int j = 32 * tj + r; const float Gj = Gs[j];
#pragma unroll
                for (int idx = 0; idx < 16; ++idx) { const int i = 32 * ti + crow(idx, hh); const float dec = __expf(Gs[i] - Gj);
                    if (prod == 0) Ls[i * 64 + (j & 7) * 8 + (j >> 3)] = (i > j) ? Bs[i] * acc[idx] * dec : 0.f;
                    else As[i * 64 + (j & 48) + perm16(j & 15)] = (bf16)((i >= j) ? f2bf(acc[idx] * dec) : 0u); }
            } else if (wave == 6) {
#pragma unroll
                for (int e = 0; e < 4; ++e) { const int id = lane + 64 * e, i = id >> 3, q8 = id & 7; *(LAS f32x4*)(Ls + i * 64 + q8 * 8 + 4) = (f32x4){0.f, 0.f, 0.f, 0.f}; }
            } else {
#pragma unroll
                for (int e = 0; e < 8; ++e) *(LAS v4u*)(lds + DP_T + (lane + 64 * e) * 16) = (v4u){0u, 0u, 0u, 0u};
#pragma unroll
                for (int e = 0; e < 2; ++e) { const int id = lane + 64 * e, i = id >> 2, c4 = id & 3; *(LAS v4u*)(lds + DP_A + i * 128 + 64 + c4 * 16) = (v4u){0u, 0u, 0u, 0u}; }
            }
        }
        LBAR();
        {
            const int cl = lane >> 3, q8 = lane & 7, col = 8 * wave + cl;
            float xs[8];
#pragma unroll
            for (int k = 0; k < 8; ++k) xs[k] = 0.f;
            const LAS float* Lp = (const LAS float*)(lds + DP_L) + q8 * 8;
            LAS bf16* Ts = (LAS bf16*)(lds + DP_T);
#pragma unroll
            for (int i = 0; i < 64; ++i) {
                if (i >= 8 * wave) {
                    const f32x4 l0 = *(const LAS f32x4*)(Lp + i * 64), l1 = *(const LAS f32x4*)(Lp + i * 64 + 4);
                    float s = 0.f;
#pragma unroll
                    for (int kk = 0; kk < 8; ++kk) if (8 * kk < i) s += ((kk < 4) ? l0[kk & 3] : l1[kk & 3]) * xs[kk];
                    s += dppf<0xB1>(s); s += dppf<0x4E>(s); s += dppf<0x141>(s);
                    const float xi = ((i == col) ? 1.f : 0.f) - s;
                    if ((i & 7) == q8) { xs[i >> 3] = xi; Ts[i * 64 + (col & 48) + perm16(col & 15)] = (bf16)f2bf(xi); }
                }
            }
        }
        LBAR();
        { const size_t ib = (((size_t)(b * 8 + h)) * 64 + c) * 4096;
          *(v4u*)(TB + ib + tid * 8) = *(const LAS v4u*)(lds + DP_T + tid * 16); *(v4u*)(AB + ib + tid * 8) = *(const LAS v4u*)(lds + DP_A + tid * 16); }
    }
    LBAR();
#undef DP_PREFETCH
}

constexpr int SQ_K = 0, SQ_Q = 16384, SQ_V = 32768, SQ_T = 49152, SQ_A = 58368, SQ_EG = 67584, SQ_ED = 67904, SQ_BT = 68160, SQ_SZ = 68416;
__device__ __forceinline__ void dn_seq(LAS unsigned char* lds, const bf16* P, const bf16* DQ, const bf16* DK, const bf16* DV, const float* BETA, const float* GG, const bf16* TB, const bf16* AB,
                                       bf16* YB, const float* og, int b, int h, int tid, int lane, int wave) {
    const size_t rowb = (size_t)b * SEQ;
    const size_t ibh = ((size_t)(b * 8 + h)) * 64 * 4096;
    if (wave >= 4) {
        int lt = tid - 256;
        v4u rk[4], rq[4], rv[4], rt[2], ra[2]; float gG = 0.f, gB = 0.f;
#define DN_LOAD(c) do { asm volatile("" : "+v"(lt)); \
        _Pragma("unroll") for (int i = 0; i < 4; ++i) { const int e = lt + 256 * i, row = e >> 4, ch = e & 15; const size_t go = (rowb + (size_t)(c) * 64 + row) * 1024 + h * 128 + 8 * ch; \
            rk[i] = *(const v4u*)(DK + go); rq[i] = *(const v4u*)(DQ + go); rv[i] = *(const v4u*)(DV + go); } \
        _Pragma("unroll") for (int i = 0; i < 2; ++i) { const int e = lt + 256 * i; rt[i] = *(const v4u*)(TB + ibh + (size_t)(c) * 4096 + e * 8); ra[i] = *(const v4u*)(AB + ibh + (size_t)(c) * 4096 + e * 8); } \
        if (wave == 4) { gG = GG[(rowb + (size_t)(c) * 64 + lane) * 8 + h]; gB = BETA[(rowb + (size_t)(c) * 64 + lane) * 8 + h]; } } while (0)
#define DN_STORE(buf) do { asm volatile("" : "+v"(lt)); LAS unsigned char* bb = lds + (buf) * SQ_SZ; \
        _Pragma("unroll") for (int i = 0; i < 4; ++i) { const int e = lt + 256 * i, row = e >> 4, ch = e & 15; const int sw = row * 256 + ((ch ^ (row & 15)) << 4); \
            *(LAS v4u*)(bb + SQ_K + sw) = rk[i]; *(LAS v4u*)(bb + SQ_Q + sw) = rq[i]; *(LAS v4u*)(bb + SQ_V + row * 256 + ch * 16) = rv[i]; } \
        _Pragma("unroll") for (int i = 0; i < 2; ++i) { const int e = lt + 256 * i, row = e >> 3, c8 = e & 7; *(LAS v4u*)(bb + SQ_T + row * 144 + c8 * 16) = rt[i]; *(LAS v4u*)(bb + SQ_A + row * 144 + c8 * 16) = ra[i]; } \
        if (wave == 4) { const float gl = __shfl(gG, 63); ((LAS float*)(bb + SQ_EG))[lane] = __expf(gG); ((LAS float*)(bb + SQ_ED))[lane] = __expf(gl - gG); ((LAS float*)(bb + SQ_BT))[lane] = gB; \
            if (lane == 63) ((LAS float*)(bb + SQ_EG))[64] = __expf(gl); } } while (0)
        DN_LOAD(0); DN_STORE(0); DN_LOAD(1);
        LBAR();
        for (int c = 0; c < 64; ++c) {
            if (c + 1 < 64) { DN_STORE((c + 1) & 1); if (c + 2 < 64) DN_LOAD(c + 2); }
            asm volatile("" : "+v"(lt));
            const int orow = lt >> 2, oq = lt & 3;
            const size_t grow = rowb + (size_t)c * 64 + orow;
            v4u zr[4];
#pragma unroll
            for (int j = 0; j < 4; ++j) zr[j] = *(const v4u*)(P + grow * NP + C_DZ + h * 128 + 32 * oq + 8 * j);
            LBAR();
            {
                const LAS unsigned char* ob = lds + (c & 1) * SQ_SZ + SQ_V + orow * 256 + 64 * oq;
                v4u ov[4]; float ss = 0.f;
#pragma unroll
                for (int j = 0; j < 4; ++j) { ov[j] = *(const LAS v4u*)(ob + 16 * j);
#pragma unroll
                    for (int e = 0; e < 4; ++e) { const float x0 = bflo(ov[j][e]), x1 = bfhi(ov[j][e]); ss += x0 * x0 + x1 * x1; } }
                ss += dppf<0xB1>(ss); ss += dppf<0x4E>(ss);
                const float rinv = rsqrtf(ss * (1.f / 128) + EPS);
                bf16* yp = YB + grow * 1024 + h * 128 + 32 * oq;
#pragma unroll
                for (int j = 0; j < 4; ++j) { const f32x4 ga = *(const f32x4*)(og + 32 * oq + 8 * j), gb = *(const f32x4*)(og + 32 * oq + 8 * j + 4);
                    v4u w;
                    w.x = pk2(bflo(ov[j].x) * rinv * ga.x * siluf_(bflo(zr[j].x)), bfhi(ov[j].x) * rinv * ga.y * siluf_(bfhi(zr[j].x)));
                    w.y = pk2(bflo(ov[j].y) * rinv * ga.z * siluf_(bflo(zr[j].y)), bfhi(ov[j].y) * rinv * ga.w * siluf_(bfhi(zr[j].y)));
                    w.z = pk2(bflo(ov[j].z) * rinv * gb.x * siluf_(bflo(zr[j].z)), bfhi(ov[j].z) * rinv * gb.y * siluf_(bfhi(zr[j].z)));
                    w.w = pk2(bflo(ov[j].w) * rinv * gb.z * siluf_(bflo(zr[j].w)), bfhi(ov[j].w) * rinv * gb.w * siluf_(bfhi(zr[j].w)));
                    *(v4u*)(yp + 8 * j) = w; }
            }
            LBAR();
        }
#undef DN_LOAD
#undef DN_STORE
    } else {
        const int w = wave;
        f32x16 S[4];
#pragma unroll
        for (int kt = 0; kt < 4; ++kt)
#pragma unroll
            for (int i = 0; i < 16; ++i) S[kt][i] = 0.f;
        LBAR();
        for (int c = 0; c < 64; ++c) {
            int ln = lane; asm volatile("" : "+v"(ln));
            const int r = ln & 31, hh = ln >> 5, q4 = (ln & 15) >> 2, p4 = ln & 3, grp = (ln >> 4) & 1;
            const LAS unsigned char* bb = lds + (c & 1) * SQ_SZ;
            const LAS float* EG = (const LAS float*)(bb + SQ_EG); const LAS float* ED = (const LAS float*)(bb + SQ_ED); const LAS float* BT = (const LAS float*)(bb + SQ_BT);
            f32x16 ks[2], qs[2];
#pragma unroll
            for (int ti = 0; ti < 2; ++ti)
#pragma unroll
                for (int i = 0; i < 16; ++i) { ks[ti][i] = 0.f; qs[ti][i] = 0.f; }
            {
                const LAS unsigned char* kr0 = bb + SQ_K + r * 256; const LAS unsigned char* qr0 = bb + SQ_Q + r * 256;
                bf16x8 ka0, ka1, qa0, qa1;
                { const int off = ((0 + hh) ^ (r & 15)) << 4; ka0 = *(const LAS bf16x8*)(kr0 + off); ka1 = *(const LAS bf16x8*)(kr0 + 8192 + off); qa0 = *(const LAS bf16x8*)(qr0 + off); qa1 = *(const LAS bf16x8*)(qr0 + 8192 + off); }
#pragma unroll
                for (int it = 0; it < 8; ++it) {
                    bf16x8 kb0 = ka0, kb1 = ka1, qb0 = qa0, qb1 = qa1;
                    if (it < 7) { const int off = ((2 * (it + 1) + hh) ^ (r & 15)) << 4; kb0 = *(const LAS bf16x8*)(kr0 + off); kb1 = *(const LAS bf16x8*)(kr0 + 8192 + off); qb0 = *(const LAS bf16x8*)(qr0 + off); qb1 = *(const LAS bf16x8*)(qr0 + 8192 + off); }
                    const bf16x8 sf = pack8(S[it >> 1], it & 1);
                    ks[0] = __builtin_amdgcn_mfma_f32_32x32x16_bf16(ka0, sf, ks[0], 0, 0, 0);
                    qs[0] = __builtin_amdgcn_mfma_f32_32x32x16_bf16(qa0, sf, qs[0], 0, 0, 0);
                    ks[1] = __builtin_amdgcn_mfma_f32_32x32x16_bf16(ka1, sf, ks[1], 0, 0, 0);
                    qs[1] = __builtin_amdgcn_mfma_f32_32x32x16_bf16(qa1, sf, qs[1], 0, 0, 0);
                    ka0 = kb0; ka1 = kb1; qa0 = qb0; qa1 = qb1;
                }
            }
#pragma unroll
            for (int ti = 0; ti < 2; ++ti)
#pragma unroll
                for (int g = 0; g < 4; ++g) { const int t0 = 32 * ti + 8 * g + 4 * hh;
                    const s16x4 vv = tr_read(bb + SQ_V + (t0 + q4) * 256 + (32 * w + 16 * grp + 4 * p4) * 2);
                    const f32x4 eg = *(const LAS f32x4*)(EG + t0), bt = *(const LAS f32x4*)(BT + t0);
#pragma unroll
                    for (int e = 0; e < 4; ++e) { const int i = 4 * g + e; ks[ti][i] = bt[e] * (bfs(vv[e]) - eg[e] * ks[ti][i]); qs[ti][i] = eg[e] * qs[ti][i]; } }
            f32x16 vn[2];
#pragma unroll
            for (int ti = 0; ti < 2; ++ti)
#pragma unroll
                for (int i = 0; i < 16; ++i) vn[ti][i] = 0.f;
            {
                bf16x8 rf[2][2];
#pragma unroll
                for (int tj = 0; tj < 2; ++tj)
#pragma unroll
                    for (int s = 0; s < 2; ++s) rf[tj][s] = pack8(ks[tj], s);
                const LAS unsigned char* tr0 = bb + SQ_T + r * 144 + 16 * hh;
                bf16x8 tf[6];
#pragma unroll
                for (int s = 0; s < 2; ++s) { tf[s] = *(const LAS bf16x8*)(tr0 + 32 * s); tf[2 + s] = *(const LAS bf16x8*)(tr0 + 32 * 144 + 32 * s); tf[4 + s] = *(const LAS bf16x8*)(tr0 + 32 * 144 + 64 + 32 * s); }
#pragma unroll
                for (int s = 0; s < 2; ++s) {
                    vn[0] = __builtin_amdgcn_mfma_f32_32x32x16_bf16(tf[s], rf[0][s], vn[0], 0, 0, 0);
                    vn[1] = __builtin_amdgcn_mfma_f32_32x32x16_bf16(tf[2 + s], rf[0][s], vn[1], 0, 0, 0); }
#pragma unroll
                for (int s = 0; s < 2; ++s) vn[1] = __builtin_amdgcn_mfma_f32_32x32x16_bf16(tf[4 + s], rf[1][s], vn[1], 0, 0, 0);
            }
            bf16x8 df[2][2];
            {
                bf16x8 vf[2][2];
#pragma unroll
                for (int tj = 0; tj < 2; ++tj)
#pragma unroll
                    for (int s = 0; s < 2; ++s) vf[tj][s] = pack8(vn[tj], s);
                const LAS unsigned char* ar0 = bb + SQ_A + r * 144 + 16 * hh;
                bf16x8 af[6];
#pragma unroll
                for (int s = 0; s < 2; ++s) { af[s] = *(const LAS bf16x8*)(ar0 + 32 * s); af[2 + s] = *(const LAS bf16x8*)(ar0 + 32 * 144 + 32 * s); af[4 + s] = *(const LAS bf16x8*)(ar0 + 32 * 144 + 64 + 32 * s); }
#pragma unroll
                for (int s = 0; s < 2; ++s) {
                    qs[0] = __builtin_amdgcn_mfma_f32_32x32x16_bf16(af[s], vf[0][s], qs[0], 0, 0, 0);
                    qs[1] = __builtin_amdgcn_mfma_f32_32x32x16_bf16(af[2 + s], vf[0][s], qs[1], 0, 0, 0); }
#pragma unroll
                for (int s = 0; s < 2; ++s) qs[1] = __builtin_amdgcn_mfma_f32_32x32x16_bf16(af[4 + s], vf[1][s], qs[1], 0, 0, 0);
#pragma unroll
                for (int ti = 0; ti < 2; ++ti)
#pragma unroll
                    for (int g = 0; g < 4; ++g) { const f32x4 ed = *(const LAS f32x4*)(ED + 32 * ti + 8 * g + 4 * hh);
#pragma unroll
                        for (int e = 0; e < 4; ++e) vn[ti][4 * g + e] *= ed[e]; }
#pragma unroll
                for (int tj = 0; tj < 2; ++tj)
#pragma unroll
                    for (int s = 0; s < 2; ++s) df[tj][s] = pack8(vn[tj], s);
            }
            {
                LAS bf16* op = (LAS bf16*)(lds + (c & 1) * SQ_SZ + SQ_V) + 32 * w + r;
#pragma unroll
                for (int ti = 0; ti < 2; ++ti)
#pragma unroll
                    for (int i = 0; i < 16; ++i) op[(32 * ti + crow(i, hh)) * 128] = (bf16)f2bf(qs[ti][i]);
            }
            LBAR();
            {
                const float egl = EG[64];
#pragma unroll
                for (int kt = 0; kt < 4; ++kt)
#pragma unroll
                    for (int i = 0; i < 16; ++i) S[kt][i] *= egl;
                const int pp = (p4 == 1) ? 2 : ((p4 == 2) ? 1 : p4);
                const int cb = 2 * grp + (pp >> 1), b8 = 8 * (pp & 1);
                s16x4 lo[4], hi[4];
#define DN_KT_LOAD(tj, s) do { const int klo = 32 * (tj) + 16 * (s) + 4 * hh + q4, khi = klo + 8; \
                _Pragma("unroll") for (int kt = 0; kt < 4; ++kt) { lo[kt] = tr_read(bb + SQ_K + klo * 256 + (((4 * kt + cb) ^ (klo & 15)) << 4) + b8); hi[kt] = tr_read(bb + SQ_K + khi * 256 + (((4 * kt + cb) ^ (khi & 15)) << 4) + b8); } } while (0)
                DN_KT_LOAD(0, 0);
#pragma unroll
                for (int it = 0; it < 4; ++it) {
                    bf16x8 kf[4];
#pragma unroll
                    for (int kt = 0; kt < 4; ++kt) kf[kt] = __builtin_shufflevector(lo[kt], hi[kt], 0, 1, 2, 3, 4, 5, 6, 7);
                    if (it < 3) DN_KT_LOAD((it + 1) >> 1, (it + 1) & 1);
#pragma unroll
                    for (int kt = 0; kt < 4; ++kt) S[kt] = __builtin_amdgcn_mfma_f32_32x32x16_bf16(kf[kt], df[it >> 1][it & 1], S[kt], 0, 0, 0);
                }
#undef DN_KT_LOAD
            }
            LBAR();
        }
    }
}

#define XB_TMO      128
#define XB_XCNT(j)  (256  + 64 * (j))
#define XB_XSUB(j)  (1280 + 64 * (j))
#define XB_XGEN(j)  (2304 + 64 * (j))
#define XB_TOP      3328
#define XB_TOPGEN   3392
#define XCD_BAR_WORDS 3456
#define XB_SPIN_CAP (1u << 18)

__device__ __forceinline__ unsigned xb_ld(unsigned* p)              { return __hip_atomic_load(p, __ATOMIC_RELAXED, __HIP_MEMORY_SCOPE_AGENT); }
__device__ __forceinline__ unsigned xb_add(unsigned* p, unsigned v) { return __hip_atomic_fetch_add(p, v, __ATOMIC_RELAXED, __HIP_MEMORY_SCOPE_AGENT); }
__device__ __forceinline__ unsigned xb_xcc_id() { return (unsigned)__builtin_amdgcn_s_getreg((3 << 11) | 20) & 0xFu; }
#define XB_SPIN(cond, bar) do { unsigned _sp = 0; while (cond) { __builtin_amdgcn_s_sleep(1); \
    if ((++_sp & 255u) == 0u) { if (xb_ld(&(bar)[XB_TMO])) break; if (_sp > XB_SPIN_CAP) { atomicAdd(&(bar)[XB_TMO], 1u); break; } } } } while (0)

struct XcdBarrier {
    unsigned* bar; unsigned x;
    volatile LAS unsigned* st;
};

__device__ __forceinline__ XcdBarrier xcd_barrier_post(unsigned* bar, volatile LAS unsigned* st) {
    XcdBarrier b; b.bar = bar; b.x = xb_xcc_id(); b.st = st;
    if (threadIdx.x == 0) (void)xb_add(&bar[XB_XCNT(b.x)], 1u);
    return b;
}
__device__ __forceinline__ void xcd_barrier_complete(unsigned* bar, unsigned x, unsigned& nloc, unsigned& nx) {
    const unsigned G = gridDim.x * gridDim.y * gridDim.z;
    unsigned sum, cnt, mine, sp = 0u;
    for (;;) {
        sum = 0u; cnt = 0u; mine = 0u;
#pragma unroll
        for (unsigned j = 0; j < 16; ++j) { const unsigned c = xb_ld(&bar[XB_XCNT(j)]); sum += c; cnt += (c > 0u) ? 1u : 0u; mine = (j == x) ? c : mine; }
        if (sum == G) break;
        __builtin_amdgcn_s_sleep(1);
        if ((++sp & 255u) == 0u) { if (xb_ld(&bar[XB_TMO])) break; if (sp > XB_SPIN_CAP) { atomicAdd(&bar[XB_TMO], 1u); break; } }
    }
    nloc = mine > 0u ? mine : 1u; nx = cnt > 0u ? cnt : 1u;
}

__device__ __forceinline__ void xcd_barrier(const XcdBarrier& b) {
    asm volatile("s_waitcnt vmcnt(0)" ::: "memory");
    __syncthreads();
    if (threadIdx.x == 0) {
        unsigned* bar = b.bar;
        __builtin_amdgcn_s_waitcnt(0);
        unsigned nloc = b.st[0], nx = b.st[1];
        if (nloc == 0u) { xcd_barrier_complete(bar, b.x, nloc, nx); b.st[0] = nloc; b.st[1] = nx; }
        const unsigned old = xb_add(&bar[XB_XSUB(b.x)], 1u);
        const unsigned gen = old / nloc;
        if (old + 1u == (gen + 1u) * nloc) {
            __builtin_amdgcn_fence(__ATOMIC_RELEASE, "agent");
            asm volatile("s_waitcnt vmcnt(0)" ::: "memory");
            const unsigned og = xb_add(&bar[XB_TOP], 1u);
            const unsigned tg = og / nx;
            if (og + 1u == (tg + 1u) * nx) xb_add(&bar[XB_TOPGEN], 1u);
            else XB_SPIN(xb_ld(&bar[XB_TOPGEN]) == tg, bar);
            __builtin_amdgcn_fence(__ATOMIC_ACQUIRE, "agent");
            xb_add(&bar[XB_XGEN(b.x)], 1u);
            asm volatile("s_waitcnt vmcnt(0)" ::: "memory");
        } else {
            XB_SPIN(xb_ld(&bar[XB_XGEN(b.x)]) == gen, bar);
            __builtin_amdgcn_fence(__ATOMIC_ACQUIRE, "agent");
            asm volatile("s_waitcnt vmcnt(0)" ::: "memory");
        }
    }
    __syncthreads();
}

struct Args { const float* in[17]; float* out; unsigned char* ws; int ph_lo, ph_hi; };

__device__ __forceinline__ void transpose_item(const float* W, int ldw, int K, bf16* WT, int item, int nblk, int split, LAS float* scr, int lane) {
    const int kb = item / nblk, nb = item % nblk, k0 = 64 * kb, n0 = 32 * nb;
    const int s0 = (split == 2) ? ((nb >> 2) & 1) * DFF + 128 * (nb >> 3) + 32 * (nb & 3)
                                : n0 + ((split == 1 && n0 >= C_GA) ? 16 : 0);
#pragma unroll 8
    for (int i = 0; i < 32; ++i) { const int kk = 2 * i + (lane >> 5); scr[kk * 33 + (lane & 31)] = W[(size_t)(k0 + kk) * ldw + s0 + (lane & 31)]; }
    asm volatile("s_waitcnt lgkmcnt(0)" ::: "memory");
    const int c = lane & 7;
#pragma unroll
    for (int j = 0; j < 4; ++j) { const int n = (lane >> 3) + 8 * j; const LAS float* s = scr + (8 * c) * 33 + n;
        v4u o; o.x = pk2(s[0 * 33], s[1 * 33]); o.y = pk2(s[2 * 33], s[3 * 33]); o.z = pk2(s[4 * 33], s[5 * 33]); o.w = pk2(s[6 * 33], s[7 * 33]);
        *(v4u*)(WT + (size_t)(n0 + n) * K + k0 + 8 * c) = o; }
    asm volatile("s_waitcnt lgkmcnt(0)" ::: "memory");
}

__device__ __forceinline__ void rms_row(const float* xrow, const float* gain, bf16* orow, int lane) {
    const f32x4* xr = (const f32x4*)xrow + lane;
    f32x4 v[8]; float s = 0.f;
#pragma unroll
    for (int j = 0; j < 8; ++j) { v[j] = xr[64 * j]; s += (v[j].x * v[j].x + v[j].y * v[j].y) + (v[j].z * v[j].z + v[j].w * v[j].w); }
    const float rinv = rsqrtf(wave_sum(s) * (1.f / DM) + EPS);
    const f32x4* gp = (const f32x4*)gain + lane;
    unsigned long long* o8 = (unsigned long long*)orow + lane;
#pragma unroll
    for (int j = 0; j < 8; ++j) { const f32x4 g = gp[64 * j];
        o8[64 * j] = (unsigned long long)pk2(v[j].x * rinv * g.x, v[j].y * rinv * g.y) | ((unsigned long long)pk2(v[j].z * rinv * g.z, v[j].w * rinv * g.w) << 32); }
}

__device__ __forceinline__ void rms_row_bf16(const bf16* xrow, const float* gain, bf16* orow, int lane) {
    const v4u* xr = (const v4u*)xrow + lane;
    v4u v[4]; float s = 0.f;
#pragma unroll
    for (int j = 0; j < 4; ++j) { v[j] = xr[64 * j];
#pragma unroll
        for (int e = 0; e < 4; ++e) { const float a = bflo(v[j][e]), b = bfhi(v[j][e]); s += a * a + b * b; } }
    const float rinv = rsqrtf(wave_sum(s) * (1.f / DM) + EPS);
    v4u* o = (v4u*)orow + lane;
#pragma unroll
    for (int j = 0; j < 4; ++j) { const f32x4 g0 = *(const f32x4*)(gain + 8 * (lane + 64 * j)), g1 = *(const f32x4*)(gain + 8 * (lane + 64 * j) + 4);
        v4u w; w.x = pk2(bflo(v[j].x) * rinv * g0.x, bfhi(v[j].x) * rinv * g0.y); w.y = pk2(bflo(v[j].y) * rinv * g0.z, bfhi(v[j].y) * rinv * g0.w);
        w.z = pk2(bflo(v[j].z) * rinv * g1.x, bfhi(v[j].z) * rinv * g1.y); w.w = pk2(bflo(v[j].w) * rinv * g1.z, bfhi(v[j].w) * rinv * g1.w);
        o[64 * j] = w; }
}

__global__ void __launch_bounds__(512, 2) mega(Args a) {
    extern __shared__ __attribute__((aligned(16))) unsigned char lds_raw[];
    cg::grid_group grid = cg::this_grid();
    LAS unsigned char* lds = (LAS unsigned char*)lds_raw;
    const int G = gridDim.x, NGW = G * 8;
    unsigned char* ws = a.ws;
    bf16* WB = (bf16*)(ws + WS_W);
    bf16* P = (bf16*)(ws + WS_P);
    bf16* H = (bf16*)(ws + WS_R + R_H);
    bf16* YA = (bf16*)(ws + WS_R + R_YA);
    bf16* YB = (bf16*)(ws + WS_R + R_YB);
    bf16* MG = (bf16*)(ws + WS_R + R_MG);
    bf16* XM = (bf16*)(ws + WS_R + R_YA);
    bf16* ACT = (bf16*)(ws + WS_P);
    bf16* PRAW = (bf16*)(ws + WS_P + 180 * MiB);
    bf16* DQ = (bf16*)(ws + WS_R + R_DQ);
    bf16* DK = (bf16*)(ws + WS_R + R_DK);
    bf16* DV = (bf16*)(ws + WS_R + R_DV);
    bf16* TB = (bf16*)(ws + WS_R + R_TB);
    bf16* AB = (bf16*)(ws + WS_R + R_AB);
    float* BETA = (float*)(ws + WS_BG);
    float* GG = BETA + (size_t)TT * 8;
    float* KM = (float*)(ws + WS_KM);
    volatile LAS unsigned* bst = (volatile LAS unsigned*)(lds + LDS_BYTES - 16);
    if (threadIdx.x < 4) bst[threadIdx.x] = 0u;
    __syncthreads();
    const XcdBarrier xbar = xcd_barrier_post((unsigned*)(ws + 65536), bst);
    unsigned* ctr = (unsigned*)ws;
    if (blockIdx.x == 0 && threadIdx.x == 0 && a.ph_lo == 0) { ctr[0] = 0u; ctr[1] = 0u; ctr[2] = 0u; ctr[3] = 0u; }

#ifndef PROBE_MASK
#define PROBE_MASK 0
#endif
    for (int it = 2 * a.ph_lo; it < 2 * a.ph_hi; ++it) {
        const int ph = it >> 1, rep = it & 1;
        const int l = ph / NPH, p = ph % NPH;
        if (rep == 1 && !((PROBE_MASK >> p) & 1)) continue;
        if (p == 4) continue;
        int tid = threadIdx.x; asm volatile("" : "+v"(tid));
        const int lane = tid & 63, wave = __builtin_amdgcn_readfirstlane(tid >> 6), gw = blockIdx.x * 8 + wave;
        const float* xin = (l == 0) ? a.in[0] : a.out;

        if (p == 0) {
            LAS float* scr = (LAS float*)(lds + wave * 16384);
            const float* w_in = a.in[2] + (size_t)l * DM * INC;
            const float* w_a = a.in[9] + (size_t)l * 1024 * DM;
            const float* w_b = a.in[10] + (size_t)l * 1024 * DM;
            const float* w_o = a.in[11] + (size_t)l * DM * DM;
            const float* w_fi = a.in[13] + (size_t)l * DM * NP;
            const float* w_fd = a.in[16] + (size_t)l * DFF * DM;
            constexpr int I_IN = 32 * 352, I_BA = 32;
            for (int it = gw; it < I_IN + I_BA; it += NGW) {
                if (it < I_IN) transpose_item(w_in, INC, DM, WB + W_IN, it, 352, 1, scr, lane);
                else transpose_item(w_in + C_GA, INC, DM, WB + W_BA, it - I_IN, 1, 0, scr, lane);
            }
            const float* gain = a.in[1] + (size_t)l * DM;
            for (int row = gw; row < TT; row += NGW) rms_row(xin + (size_t)row * DM, gain, H + (size_t)row * DM, lane);
        }
        else if (p == 1 || p == 8) {
            pg8::Gemm g{H, WB + (p == 1 ? W_IN : W_FI), TT, NP, DM}; pg8::StaticOrder S; S.init(TT, NP, G, (int)blockIdx.x);
            if (p == 1) { pg8::EpiProj E{P, NP, a.in[3] + l * 128, a.in[4] + l * 128, KM, (LAS float*)(lds + 131072), QSCALE_L2E, EPS}; pg8::gemm_phase<pg8::EpiProj, pg8::StaticOrder, true, true>(lds, g, S, E); }
            else { pg8::EpiGLU E{ACT, PRAW, a.in[14] + (size_t)l * 3 * DFF, a.in[15] + (size_t)l * DFF, (LAS float*)(lds + 131072)};
                   pg8::gemm_phase<pg8::EpiGLU, pg8::StaticOrder, true, true>(lds, g, S, E); }
            if (p == 1) {
            __syncthreads();
            for (int tp = blockIdx.x; tp < TT / 64; tp += G) {
                const int r = lane & 31, hh = lane >> 5, tile = 2 * tp + (wave >> 2), kq = wave & 3;
                const float* alog = a.in[6] + l * 8; const float* dtb = a.in[7] + l * 8;
                const bf16* ap = H + (size_t)(tile * 32 + r) * DM + 512 * kq + 8 * hh;
                const bf16* bp = WB + W_BA + (size_t)r * DM + 512 * kq + 8 * hh;
                f32x16 acc;
#pragma unroll
                for (int i = 0; i < 16; ++i) acc[i] = 0.f;
#pragma unroll 16
                for (int k0 = 0; k0 < 512; k0 += 16) {
                    const bf16x8 av = *(const bf16x8*)(ap + k0); const bf16x8 bv = *(const bf16x8*)(bp + k0);
                    acc = __builtin_amdgcn_mfma_f32_32x32x16_bf16(av, bv, acc, 0, 0, 0);
                }
                LAS float* part = (LAS float*)lds + (wave * 64 + lane) * 16;
#pragma unroll
                for (int i = 0; i < 4; ++i) *(LAS f32x4*)(part + 4 * i) = (f32x4){acc[4 * i], acc[4 * i + 1], acc[4 * i + 2], acc[4 * i + 3]};
                __syncthreads();
                if (kq == 0 && r < 16) {
#pragma unroll
                    for (int q = 1; q < 4; ++q)
#pragma unroll
                        for (int i = 0; i < 4; ++i) { const f32x4 t = *(const LAS f32x4*)(part + q * 1024 + 4 * i); acc[4 * i] += t[0]; acc[4 * i + 1] += t[1]; acc[4 * i + 2] += t[2]; acc[4 * i + 3] += t[3]; }
                    const int hd = r & 7; const float A = __expf(alog[hd]), db = dtb[hd];
#pragma unroll
                    for (int i = 0; i < 16; ++i) { const int row = tile * 32 + crow(i, hh); const float v = acc[i];
                        if (r < 8) BETA[(size_t)row * 8 + hd] = 1.f / (1.f + __expf(-v));
                        else { const float z = v + db; const float sp = (z > 20.f) ? z : log1pf(__expf(z)); GG[(size_t)row * 8 + hd] = -A * sp; } }
                }
                __syncthreads();
            }
            }
        }
        else if (p == 2) {
            {
                const float* cw = a.in[5] + (size_t)l * 4 * 3072;
                dn_prep_phase(lds, P, cw, DQ, DK, DV, BETA, GG, TB, AB, G, tid, wave);
            }
        }
        else if (p == 3) {
            for (int item = blockIdx.x; item < 32; item += G) dn_seq(lds, P, DQ, DK, DV, BETA, GG, TB, AB, YB, a.in[8] + l * 128, item >> 3, item & 7, tid, lane, wave);
            __syncthreads();
            {
                LAS int* itemp = (LAS int*)(lds + LDS_BYTES - 32);
                constexpr int I_A = 16 * 64, I_O = 32 * 64, I_FI = 32 * 352, I_FD = 88 * 64, NFILL = (2 * I_A + I_O + I_FI + I_FD) / 32;
                for (;;) {
                    if (tid == 0) *itemp = (int)__hip_atomic_fetch_add(ctr + 2 * l + rep, 1u, __ATOMIC_RELAXED, __HIP_MEMORY_SCOPE_AGENT);
                    __syncthreads();
                    const int it = *itemp;
                    __syncthreads();
                    if (it >= 512 + NFILL) break;
                    if (it < 512) { const int qb = 15 - (it >> 5), bh = it & 31; moba_item(lds, P, KM, YA, bh >> 3, bh & 7, qb, tid, lane, wave); }
                    else {
                        LAS float* scr = (LAS float*)(lds + wave * 16384);
#pragma unroll 1
                        for (int j = 0; j < 4; ++j) { int r = (it - 512) * 32 + j * 8 + wave;
                            const float* W; int ldw, K, nblk, split; size_t doff;
                            if (r < I_A) { W = a.in[9] + (size_t)l * 1024 * DM; ldw = DM; K = 1024; nblk = 64; split = 0; doff = W_A; }
                            else if ((r -= I_A) < I_A) { W = a.in[10] + (size_t)l * 1024 * DM; ldw = DM; K = 1024; nblk = 64; split = 0; doff = W_B; }
                            else if ((r -= I_A) < I_O) { W = a.in[11] + (size_t)l * DM * DM; ldw = DM; K = DM; nblk = 64; split = 0; doff = W_O; }
                            else if ((r -= I_O) < I_FI) { W = a.in[13] + (size_t)l * DM * NP; ldw = NP; K = DM; nblk = 352; split = 2; doff = W_FI; }
                            else { r -= I_FI; W = a.in[16] + (size_t)l * DFF * DM; ldw = DM; K = DFF; nblk = 64; split = 0; doff = W_FD; }
                            transpose_item(W, ldw, K, WB + doff, r, nblk, split, scr, lane); }
                    }
                }
            }
        }
        else if (p == 4) {
            const float* og = a.in[8] + l * 128;
            const float og0 = og[2 * lane], og1 = og[2 * lane + 1];
            for (int idx = gw; idx < TT * 8; idx += NGW) {
                const int row = idx >> 3, h = idx & 7;
                const unsigned uo = *(const unsigned*)(P + (size_t)row * NP + C_DQ + h * 128 + 2 * lane);
                const unsigned uz = *(const unsigned*)(P + (size_t)row * NP + C_DZ + h * 128 + 2 * lane);
                const float o0 = bflo(uo), o1 = bfhi(uo);
                const float r = rsqrtf(wave_sum(o0 * o0 + o1 * o1) * (1.f / 128) + EPS);
                *(unsigned*)(YB + (size_t)row * 1024 + h * 128 + 2 * lane) = pk2(o0 * r * og0 * siluf_(bflo(uz)), o1 * r * og1 * siluf_(bfhi(uz)));
            }
        }
        else if (p == 5) {
            for (int pass = 0; pass < 2; ++pass) {
                pg8::Gemm g{pass ? YB : YA, WB + (pass ? W_B : W_A), TT, DM, 1024}; pg8::StaticOrder S; S.init(TT, DM, G, (int)blockIdx.x);
                pg8::EpiGate E{MG, DM, P + (pass ? C_GB : C_GA), NP, pass};
                pg8::gemm_phase<pg8::EpiGate, pg8::StaticOrder, true, true>(lds, g, S, E);
            }
        }
        else if (p == 6 || p == 10) {
            pg8::Gemm g{p == 6 ? MG : ACT, WB + (p == 6 ? W_O : W_FD), TT, DM, p == 6 ? DM : DFF}; pg8::StaticOrder S; S.init(TT, DM, G, (int)blockIdx.x);
            pg8::EpiResid E{xin, p == 6 ? (const bf16*)nullptr : (const bf16*)XM, a.out, p == 6 ? XM : (bf16*)nullptr, DM};
            pg8::gemm_phase<pg8::EpiResid, pg8::StaticOrder, true, true>(lds, g, S, E);
        }
        else if (p == 7) {
            const float* gain = a.in[12] + (size_t)l * DM;
            for (int row = gw; row < TT; row += NGW) rms_row_bf16(XM + (size_t)row * DM, gain, H + (size_t)row * DM, lane);
        }
        else if (p == 9) {
            const float* cw = a.in[14] + (size_t)l * 3 * DFF; const float* cb = a.in[15] + (size_t)l * DFF;
            for (int idx = blockIdx.x * 512 + tid; idx < 64 * (DFF / 8); idx += G * 512) {
                const int pm = idx / (DFF / 8), col = (idx % (DFF / 8)) * 8, t0 = pm * 256;
                if ((t0 & (SEQ - 1)) == 0) continue;
                float x[4][8], up[2][8];
#pragma unroll
                for (int i = 0; i < 4; ++i) { const v4u pg = *(const v4u*)(PRAW + (size_t)(i < 2 ? (pm - 1) * 4 + 2 + i : pm * 4 + i - 2) * NP + col);
#pragma unroll
                    for (int e = 0; e < 4; ++e) { x[i][2 * e] = bflo(pg[e]); x[i][2 * e + 1] = bfhi(pg[e]); } }
#pragma unroll
                for (int i = 0; i < 2; ++i) { const v4u pu = *(const v4u*)(PRAW + (size_t)(pm * 4 + i) * NP + DFF + col);
#pragma unroll
                    for (int e = 0; e < 4; ++e) { up[i][2 * e] = bflo(pu[e]); up[i][2 * e + 1] = bfhi(pu[e]); } }
#pragma unroll
                for (int i = 0; i < 2; ++i) { float r[8];
#pragma unroll
                    for (int e = 0; e < 8; ++e) { const float gt = cw[col + e] * x[i][e] + cw[DFF + col + e] * x[i + 1][e] + cw[2 * DFF + col + e] * x[i + 2][e] + cb[col + e]; r[e] = siluf_(gt) * up[i][e]; }
                    v4u w; w.x = pk2(r[0], r[1]); w.y = pk2(r[2], r[3]); w.z = pk2(r[4], r[5]); w.w = pk2(r[6], r[7]);
                    *(v4u*)(ACT + (size_t)(t0 + i) * DFF + col) = w; }
            }
        }
        if (it + 2 < 2 * a.ph_hi) xcd_barrier(xbar);
    }
    if (a.ph_lo > a.ph_hi) grid.sync();
}

extern "C" void kernel_launch(void* const* d_in, const int* in_sizes, int n_in, void* d_out, int out_size, void* d_ws, size_t ws_size, hipStream_t stream) {
    static int grid = 0;
    if (grid == 0) {
        if (n_in != 17 || out_size != TT * DM || ws_size < WS_END) { fprintf(stderr, "kernel_launch: unexpected shapes / workspace (%d inputs, out %d, ws %zu)\n", n_in, out_size, ws_size); grid = -1; return; }
        int dev = 0, cus = 0, per_cu = 0;
        if (hipGetDevice(&dev) != hipSuccess || hipDeviceGetAttribute(&cus, hipDeviceAttributeMultiprocessorCount, dev) != hipSuccess) { grid = -1; return; }
        if (hipFuncSetAttribute((const void*)mega, hipFuncAttributeMaxDynamicSharedMemorySize, LDS_BYTES) != hipSuccess) { grid = -1; return; }
        if (hipOccupancyMaxActiveBlocksPerMultiprocessor(&per_cu, (const void*)mega, 512, LDS_BYTES) != hipSuccess || per_cu < 1) { fprintf(stderr, "kernel_launch: occupancy query says %d\n", per_cu); per_cu = 1; }
        (void)hipGetLastError();
        grid = cus * per_cu;
    }
    if (grid < 0) return;
    Args a{};
    for (int i = 0; i < 17; ++i) a.in[i] = (const float*)d_in[i];
    a.out = (float*)d_out; a.ws = (unsigned char*)d_ws; a.ph_lo = 0; a.ph_hi = 2 * NPH;
    if (hipMemsetAsync(d_ws, 0, 128 * 1024, stream) != hipSuccess) { fprintf(stderr, "kernel_launch: memset of the control words failed\n"); return; }
    void* args[] = {&a};
    hipError_t e = hipLaunchCooperativeKernel((const void*)mega, dim3(grid), dim3(512), args, LDS_BYTES, stream);
    if (e != hipSuccess) fprintf(stderr, "cooperative launch failed: %s (grid %d)\n", hipGetErrorString(e), grid);
}
```

```cpp
#include <hip/hip_runtime.h>
#include <hip/hip_cooperative_groups.h>
#include <cstdio>
#include <cstdint>
namespace cg = cooperative_groups;
namespace pg8 {
#define PG8_LAS __attribute__((address_space(3)))
typedef unsigned short bf16_t;
typedef short bf16x8 __attribute__((ext_vector_type(8)));
typedef float f32x4 __attribute__((ext_vector_type(4)));
typedef unsigned u32x4 __attribute__((ext_vector_type(4)));
constexpr int BM = 256, BK = 64, HALF = 128, HTB = HALF * BK * 2  , STAGE_BYTES = 8 * HTB, NXCD = 8, WGM = 4;

__host__ __device__ __forceinline__ int lds_byte(int r, int c) { const int st = (r >> 4) * 2 + (c >> 5), rr = r & 15, cc = c & 31, ob = rr * 64 + cc * 2; return st * 1024 + (ob ^ (((ob >> 9) & 1) << 5)); }
__host__ __device__ __forceinline__ void stage_rc(int b, int& R, int& C) { const int st = b / 1024, sb = b % 1024, swz = sb ^ (((sb >> 9) & 1) << 5); R = (st >> 1) * 16 + swz / 64; C = (st & 1) * 32 + (swz % 64) / 2; }
__host__ __device__ __forceinline__ int perm32(int rho) { const int n = rho >> 4, i = rho & 15; return 8 * (i >> 2) + 4 * n + (i & 3); }

struct Unit { int pm, pn; };
struct Gemm { const bf16_t* A; const bf16_t* Bt; int M, N, K; };

struct StaticOrder {
    int nM, nN, nwg, G, c;
    __host__ __device__ void init(int M, int N, int G_, int c_) { nM = M / BM; nN = N / BM; nwg = nM * nN; G = G_; c = c_; }
    __host__ __device__ bool next(int i, Unit& u) const {
        const long L = (long)i * G + c; if (L >= nwg) return false;
        int wgid = (int)L; { const int q = nwg / NXCD, r = nwg % NXCD, xcd = wgid % NXCD, off = wgid / NXCD; wgid = (xcd < r ? xcd * (q + 1) : r * (q + 1) + (xcd - r) * q) + off; }
        const int nig = WGM * nN, gid = wgid / nig, fm = gid * WGM, gsz = (nM - fm) < WGM ? (nM - fm) : WGM;
        u.pm = fm + ((wgid % nig) % gsz); u.pn = (wgid % nig) / gsz; return true;
    }
    __device__ __forceinline__ void a_ready(const Unit&) const {}
    __device__ __forceinline__ void done(const Unit&) const {}
};

__device__ __forceinline__ unsigned cvt_pk_bf16(float lo, float hi) { unsigned r; asm volatile("v_cvt_pk_bf16_f32 %0, %1, %2" : "=v"(r) : "v"(lo), "v"(hi)); return r; }
__device__ __forceinline__ float sigm(float x) { return __builtin_amdgcn_rcpf(1.f + __expf(-x)); }
struct EpiBf16S {
    static constexpr bool PERM = true, AFTER_DRAIN = false;
    bf16_t* O; int ldc;
    __device__ __forceinline__ void operator()(const f32x4 (&acc)[2][2][4][2], const Unit& u, int wr, int wc, int fr, int fq) const {
        const int row0 = u.pm * BM + wr * 64 + fr, col0 = u.pn * BM + wc * 32 + 8 * fq;
#pragma unroll
        for (int ai = 0; ai < 2; ++ai)
#pragma unroll
            for (int m = 0; m < 4; ++m) { bf16_t* rowp = O + (size_t)(row0 + ai * HALF + m * 16) * ldc + col0;
#pragma unroll
                for (int bj = 0; bj < 2; ++bj) { const f32x4 v0 = acc[ai][bj][m][0], v1 = acc[ai][bj][m][1];
                    u32x4 w; w.x = cvt_pk_bf16(v0[0], v0[1]); w.y = cvt_pk_bf16(v0[2], v0[3]); w.z = cvt_pk_bf16(v1[0], v1[1]); w.w = cvt_pk_bf16(v1[2], v1[3]);
                    *(u32x4*)(rowp + bj * HALF) = w; } }
    }
};
struct EpiResid {
    static constexpr bool PERM = true, AFTER_DRAIN = false;
    const float* R; const bf16_t* Rb; float* O; bf16_t* Ob; int ld;
    __device__ __forceinline__ void operator()(const f32x4 (&acc)[2][2][4][2], const Unit& u, int wr, int wc, int fr, int fq) const {
        const int row0 = u.pm * BM + wr * 64 + fr, col0 = u.pn * BM + wc * 32 + 8 * fq;
#pragma unroll
        for (int ai = 0; ai < 2; ++ai)
#pragma unroll
            for (int m = 0; m < 4; ++m) { const size_t ro = (size_t)(row0 + ai * HALF + m * 16) * ld + col0;
#pragma unroll
                for (int bj = 0; bj < 2; ++bj) { const size_t off = ro + bj * HALF;
                    f32x4 r0, r1;
                    if (Rb) { const u32x4 rb = *(const u32x4*)(Rb + off);
                        r0 = (f32x4){__uint_as_float(rb.x << 16), __uint_as_float(rb.x & 0xffff0000u), __uint_as_float(rb.y << 16), __uint_as_float(rb.y & 0xffff0000u)};
                        r1 = (f32x4){__uint_as_float(rb.z << 16), __uint_as_float(rb.z & 0xffff0000u), __uint_as_float(rb.w << 16), __uint_as_float(rb.w & 0xffff0000u)}; }
                    else { r0 = *(const f32x4*)(R + off); r1 = *(const f32x4*)(R + off + 4); }
                    const f32x4 v0 = r0 + acc[ai][bj][m][0], v1 = r1 + acc[ai][bj][m][1];
                    if (Ob) { u32x4 w; w.x = cvt_pk_bf16(v0[0], v0[1]); w.y = cvt_pk_bf16(v0[2], v0[3]); w.z = cvt_pk_bf16(v1[0], v1[1]); w.w = cvt_pk_bf16(v1[2], v1[3]); *(u32x4*)(Ob + off) = w; }
                    else { *(f32x4*)(O + off) = v0; *(f32x4*)(O + off + 4) = v1; } } }
    }
};
template <int CTRL> __device__ __forceinline__ float dpp_mov(float v) { return __builtin_bit_cast(float, __builtin_amdgcn_update_dpp(0, __builtin_bit_cast(int, v), CTRL, 0xf, 0xf, false)); }
struct EpiGLU {
    static constexpr bool PERM = true, AFTER_DRAIN = false;
    bf16_t* ACT; bf16_t* Praw; const float* cw; const float* cb; PG8_LAS float* xch;
    __device__ __forceinline__ void operator()(const f32x4 (&acc)[2][2][4][2], const Unit& u, int wr, int wc, int fr, int fq) const {
        const int colg = wc * 32 + 8 * fq, j0 = u.pn * 128 + colg;
        if (fr >= 14) {
#pragma unroll
            for (int ai = 0; ai < 2; ++ai)
#pragma unroll
                for (int n = 0; n < 2; ++n) *(PG8_LAS f32x4*)(xch + (((ai * 2 + wr) * 2 + (fr - 14)) * 128 + colg + 4 * n)) = acc[ai][0][3][n];
        }
        asm volatile("s_waitcnt lgkmcnt(0)" ::: "memory"); __builtin_amdgcn_s_barrier(); asm volatile("" ::: "memory");
        f32x4 w0[2], w1[2], w2[2], bs[2];
#pragma unroll
        for (int n = 0; n < 2; ++n) { w0[n] = *(const f32x4*)(cw + j0 + 4 * n); w1[n] = *(const f32x4*)(cw + 5632 + j0 + 4 * n); w2[n] = *(const f32x4*)(cw + 2 * 5632 + j0 + 4 * n); bs[n] = *(const f32x4*)(cb + j0 + 4 * n); }
#pragma unroll
        for (int ai = 0; ai < 2; ++ai) {
            const int chunk = ai * 2 + wr;
            f32x4 a1[2], a2[2];
#pragma unroll
            for (int n = 0; n < 2; ++n) { a1[n] = (f32x4){0.f, 0.f, 0.f, 0.f}; a2[n] = a1[n]; }
            if (chunk > 0) {
#pragma unroll
                for (int n = 0; n < 2; ++n) { a1[n] = *(const PG8_LAS f32x4*)(xch + (((chunk - 1) * 2 + 1) * 128 + colg + 4 * n)); a2[n] = *(const PG8_LAS f32x4*)(xch + (((chunk - 1) * 2 + 0) * 128 + colg + 4 * n)); }
            }
#pragma unroll
            for (int m = 0; m < 4; ++m) {
                const int row = u.pm * BM + ai * HALF + wr * 64 + m * 16 + fr;
                float o[8];
#pragma unroll
                for (int n = 0; n < 2; ++n)
#pragma unroll
                    for (int e = 0; e < 4; ++e) {
                        const float g0 = acc[ai][0][m][n][e];
                        const float r1 = dpp_mov<0x121>(g0), r2 = dpp_mov<0x122>(g0);
                        float p1, p2;
                        if (m > 0) { const float gp = acc[ai][0][m > 0 ? m - 1 : 0][n][e]; p1 = dpp_mov<0x121>(gp); p2 = dpp_mov<0x122>(gp); }
                        else { p1 = a1[n][e]; p2 = (fr == 1) ? a1[n][e] : a2[n][e]; }
                        const float g1 = (fr >= 1) ? r1 : p1, g2 = (fr >= 2) ? r2 : p2;
                        const float cv = w0[n][e] * g2 + w1[n][e] * g1 + w2[n][e] * g0 + bs[n][e];
                        o[4 * n + e] = cv * __builtin_amdgcn_rcpf(1.f + __expf(-cv)) * acc[ai][1][m][n][e];
                    }
                u32x4 w; w.x = cvt_pk_bf16(o[0], o[1]); w.y = cvt_pk_bf16(o[2], o[3]); w.z = cvt_pk_bf16(o[4], o[5]); w.w = cvt_pk_bf16(o[6], o[7]);
                *(u32x4*)(ACT + (size_t)row * 5632 + j0) = w;
                if ((chunk == 0 && m == 0 && fr < 2) || (chunk == 3 && m == 3 && fr >= 14)) {
                    const f32x4 gA = acc[ai][0][m][0], gB = acc[ai][0][m][1], uA = acc[ai][1][m][0], uB = acc[ai][1][m][1];
                    u32x4 wg, wu; wg.x = cvt_pk_bf16(gA[0], gA[1]); wg.y = cvt_pk_bf16(gA[2], gA[3]); wg.z = cvt_pk_bf16(gB[0], gB[1]); wg.w = cvt_pk_bf16(gB[2], gB[3]);
                    wu.x = cvt_pk_bf16(uA[0], uA[1]); wu.y = cvt_pk_bf16(uA[2], uA[3]); wu.z = cvt_pk_bf16(uB[0], uB[1]); wu.w = cvt_pk_bf16(uB[2], uB[3]);
                    const size_t ro = (size_t)(u.pm * 4 + (chunk == 0 ? fr : fr - 12)) * 11264;
                    *(u32x4*)(Praw + ro + j0) = wg; *(u32x4*)(Praw + ro + 5632 + j0) = wu;
                }
            }
        }
    }
};
struct EpiProj {
    static constexpr bool PERM = true, AFTER_DRAIN = false;
    bf16_t* O; int ldc; const float* qgain; const float* kgain; float* KM; PG8_LAS float* xs; float qpost, eps;
    __device__ __forceinline__ void operator()(const f32x4 (&acc)[2][2][4][2], const Unit& u, int wr, int wc, int fr, int fq) const {
        const int row0 = u.pm * BM + wr * 64 + fr, col0 = u.pn * BM + wc * 32 + 8 * fq;
        if (u.pn >= 8) {
#pragma unroll
            for (int ai = 0; ai < 2; ++ai)
#pragma unroll
                for (int m = 0; m < 4; ++m) { bf16_t* rowp = O + (size_t)(row0 + ai * HALF + m * 16) * ldc + col0;
#pragma unroll
                    for (int bj = 0; bj < 2; ++bj) { const f32x4 v0 = acc[ai][bj][m][0], v1 = acc[ai][bj][m][1];
                        u32x4 w; w.x = cvt_pk_bf16(v0[0], v0[1]); w.y = cvt_pk_bf16(v0[2], v0[3]); w.z = cvt_pk_bf16(v1[0], v1[1]); w.w = cvt_pk_bf16(v1[2], v1[3]);
                        *(u32x4*)(rowp + bj * HALF) = w; } }
            return;
        }
        const bool isk = u.pn >= 4;
#pragma unroll
        for (int ai = 0; ai < 2; ++ai)
#pragma unroll
            for (int m = 0; m < 4; ++m)
#pragma unroll
                for (int bj = 0; bj < 2; ++bj) { const f32x4 a0 = acc[ai][bj][m][0], a1 = acc[ai][bj][m][1];
                    float sq = (a0[0] * a0[0] + a0[1] * a0[1]) + (a0[2] * a0[2] + a0[3] * a0[3]) + (a1[0] * a1[0] + a1[1] * a1[1]) + (a1[2] * a1[2] + a1[3] * a1[3]);
                    sq += __shfl_xor(sq, 16); sq += __shfl_xor(sq, 32);
                    if (fq == 0) xs[((((ai * 2 + wr) * 2 + bj) * 4 + m) * 16 + fr) * 4 + wc] = sq; }
        asm volatile("s_waitcnt lgkmcnt(0)" ::: "memory"); __builtin_amdgcn_s_barrier(); asm volatile("" ::: "memory");
        const float* gain = (isk ? kgain : qgain) + wc * 32 + 8 * fq;
        const f32x4 g0 = *(const f32x4*)gain, g1 = *(const f32x4*)(gain + 4);
        const float post = isk ? 1.f : qpost;
        PG8_LAS float* ks = xs + 2048;
#pragma unroll
        for (int bj = 0; bj < 2; ++bj) {
            int rq = row0; asm volatile("" : "+v"(rq));
            f32x4 c0 = (f32x4){0.f, 0.f, 0.f, 0.f}, c1 = c0;
#pragma unroll
            for (int ai = 0; ai < 2; ++ai)
#pragma unroll
                for (int m = 0; m < 4; ++m) { bf16_t* rowp = O + (size_t)(rq + ai * HALF + m * 16) * ldc + col0 + bj * HALF;
                    const f32x4 t = *(const PG8_LAS f32x4*)(xs + ((((ai * 2 + wr) * 2 + bj) * 4 + m) * 16 + fr) * 4);
                    const float rinv = rsqrtf(((t[0] + t[1]) + (t[2] + t[3])) * (1.f / 128) + eps) * post;
                    const f32x4 v0 = acc[ai][bj][m][0] * rinv * g0, v1 = acc[ai][bj][m][1] * rinv * g1;
                    c0 += v0; c1 += v1;
                    u32x4 w; w.x = cvt_pk_bf16(v0[0], v0[1]); w.y = cvt_pk_bf16(v0[2], v0[3]); w.z = cvt_pk_bf16(v1[0], v1[1]); w.w = cvt_pk_bf16(v1[2], v1[3]);
                    *(u32x4*)rowp = w; }
            if (isk) {
#pragma unroll
                for (int e = 0; e < 4; ++e) { float v = c0[e]; v += dpp_mov<0xB1>(v); v += dpp_mov<0x4E>(v); v += dpp_mov<0x141>(v); v += dpp_mov<0x140>(v); c0[e] = v;
                    float x = c1[e]; x += dpp_mov<0xB1>(x); x += dpp_mov<0x4E>(x); x += dpp_mov<0x141>(x); x += dpp_mov<0x140>(x); c1[e] = x; }
                if (fr == 0) { *(PG8_LAS f32x4*)(ks + (((wr * 2 + bj) * 4 + wc) * 4 + fq) * 8) = c0; *(PG8_LAS f32x4*)(ks + (((wr * 2 + bj) * 4 + wc) * 4 + fq) * 8 + 4) = c1; }
            }
        }
        if (isk) {
            asm volatile("s_waitcnt lgkmcnt(0)" ::: "memory"); __builtin_amdgcn_s_barrier(); asm volatile("" ::: "memory");
            if (wr == 0 && fr == 0) {
                const int b = u.pm >> 4, nb = u.pm & 15;
#pragma unroll
                for (int bj = 0; bj < 2; ++bj) { const int h = 2 * (u.pn - 4) + bj;
                    float* kmp = KM + ((size_t)(b * 8 + h) * 16 + nb) * 128 + wc * 32 + 8 * fq;
#pragma unroll
                    for (int n = 0; n < 2; ++n) { const f32x4 x0 = *(const PG8_LAS f32x4*)(ks + (((0 * 2 + bj) * 4 + wc) * 4 + fq) * 8 + n * 4), x1 = *(const PG8_LAS f32x4*)(ks + (((1 * 2 + bj) * 4 + wc) * 4 + fq) * 8 + n * 4);
                        *(f32x4*)(kmp + 4 * n) = (x0 + x1) * (1.f / 256); } }
            }
        }
    }
};
struct EpiGate {
    static constexpr bool PERM = true, AFTER_DRAIN = false;
    bf16_t* O; int ldo; const bf16_t* Gt; int ldg; int accum;
    __device__ __forceinline__ void operator()(const f32x4 (&acc)[2][2][4][2], const Unit& u, int wr, int wc, int fr, int fq) const {
        const int row0 = u.pm * BM + wr * 64 + fr, col0 = u.pn * BM + wc * 32 + 8 * fq;
#pragma unroll
        for (int ai = 0; ai < 2; ++ai)
#pragma unroll
            for (int m = 0; m < 4; ++m) { const size_t r = (size_t)(row0 + ai * HALF + m * 16);
#pragma unroll
                for (int bj = 0; bj < 2; ++bj) { const int c = col0 + bj * HALF;
                    const u32x4 gt = *(const u32x4*)(Gt + r * ldg + c);
                    const f32x4 a0 = acc[ai][bj][m][0], a1 = acc[ai][bj][m][1];
                    float v[8];
                    v[0] = a0[0] * sigm(__uint_as_float(gt.x << 16)); v[1] = a0[1] * sigm(__uint_as_float(gt.x & 0xffff0000u));
                    v[2] = a0[2] * sigm(__uint_as_float(gt.y << 16)); v[3] = a0[3] * sigm(__uint_as_float(gt.y & 0xffff0000u));
                    v[4] = a1[0] * sigm(__uint_as_float(gt.z << 16)); v[5] = a1[1] * sigm(__uint_as_float(gt.z & 0xffff0000u));
                    v[6] = a1[2] * sigm(__uint_as_float(gt.w << 16)); v[7] = a1[3] * sigm(__uint_as_float(gt.w & 0xffff0000u));
                    bf16_t* op = O + r * ldo + c;
                    if (accum) { const u32x4 pv = *(const u32x4*)op;
                        v[0] += __uint_as_float(pv.x << 16); v[1] += __uint_as_float(pv.x & 0xffff0000u);
                        v[2] += __uint_as_float(pv.y << 16); v[3] += __uint_as_float(pv.y & 0xffff0000u);
                        v[4] += __uint_as_float(pv.z << 16); v[5] += __uint_as_float(pv.z & 0xffff0000u);
                        v[6] += __uint_as_float(pv.w << 16); v[7] += __uint_as_float(pv.w & 0xffff0000u); }
                    u32x4 w; w.x = cvt_pk_bf16(v[0], v[1]); w.y = cvt_pk_bf16(v[2], v[3]); w.z = cvt_pk_bf16(v[4], v[5]); w.w = cvt_pk_bf16(v[6], v[7]);
                    *(u32x4*)op = w; } }
    }
};
template <class Epi, class Sched, bool ALIGN_EPI = false, bool SP2 = false>
__device__ __forceinline__ void gemm_phase(PG8_LAS unsigned char* lds, const Gemm g, const Sched& S, const Epi& E) {
    int tid = threadIdx.x; asm volatile("" : "+v"(tid));
    const int wid = __builtin_amdgcn_readfirstlane(tid >> 6), lane = tid & 63, wr = wid >> 2, wc = wid & 3, fr = lane & 15, fq = lane >> 4;
    const int K = g.K, nt = K / BK;
    unsigned voffA[2], voffB[2];
#pragma unroll
    for (int i = 0; i < 2; ++i) { int R, C; stage_rc(tid * 16 + i * 8192, R, C); const int Rb = Epi::PERM ? ((R & ~31) + perm32(R & 31)) : R;
        voffA[i] = (unsigned)(R * K + C) * 2u; voffB[i] = (unsigned)(Rb * K + C) * 2u; }
    const size_t kstep = (size_t)(BK * 2);
    const size_t hstep = (size_t)HALF * K * 2;
    const size_t tstep = 2 * hstep;
    const unsigned ldsw = (unsigned)wid * 1024u;
    const int aoff = lds_byte(wr * 64 + fr, fq * 8), boff = lds_byte(wc * 32 + fr, fq * 8);
#define PG8_SA(b, h) (((b) * 2 + (h)) * HTB)
#define PG8_SB(b, h) ((4 + (b) * 2 + (h)) * HTB)
#define PG8_STAGE(bufoff, gbase, voff) do { _Pragma("unroll") for (int _i = 0; _i < 2; ++_i) \
        __builtin_amdgcn_global_load_lds((const unsigned*)((const char*)(gbase) + (voff)[_i]), (PG8_LAS unsigned*)(lds + (bufoff) + ldsw + _i * 8192), 16, 0, 0); } while (0)
#define PG8_LDA(dst, b, h) do { _Pragma("unroll") for (int m = 0; m < 4; ++m) _Pragma("unroll") for (int k = 0; k < 2; ++k) dst[m][k] = *(const PG8_LAS bf16x8*)(lds + PG8_SA(b, h) + aoff + m * 2048 + k * 1024); } while (0)
#define PG8_LDB(dst, b, h) do { _Pragma("unroll") for (int n = 0; n < 2; ++n) _Pragma("unroll") for (int k = 0; k < 2; ++k) dst[n][k] = *(const PG8_LAS bf16x8*)(lds + PG8_SB(b, h) + boff + n * 2048 + k * 1024); } while (0)
#define PG8_MMA(ai, bj, At, Bt) do { __builtin_amdgcn_s_setprio(1); _Pragma("unroll") for (int m = 0; m < 4; ++m) _Pragma("unroll") for (int n = 0; n < 2; ++n) _Pragma("unroll") for (int k = 0; k < 2; ++k) \
        acc[ai][bj][m][n] = __builtin_amdgcn_mfma_f32_16x16x32_bf16(Bt[n][k], At[m][k], acc[ai][bj][m][n], 0, 0, 0); __builtin_amdgcn_s_setprio(0); } while (0)
#define PG8_WAIT_V(n) asm volatile("s_waitcnt vmcnt(" #n ")" ::: "memory")
#define PG8_WAIT_L(n) asm volatile("s_waitcnt lgkmcnt(" #n ")" ::: "memory")
#define PG8_BAR __builtin_amdgcn_s_barrier()
#define PG8_SCHED __builtin_amdgcn_sched_barrier(0)
    Unit cur, nxt; int ui = 0;
    if (!S.next(0, cur)) return;
    f32x4 acc[2][2][4][2];
#pragma unroll
    for (int a = 0; a < 2; ++a)
#pragma unroll
        for (int b = 0; b < 2; ++b)
#pragma unroll
            for (int m = 0; m < 4; ++m)
#pragma unroll
                for (int n = 0; n < 2; ++n) acc[a][b][m][n] = (f32x4){0.f, 0.f, 0.f, 0.f};
    bf16x8 At[4][2], B0[2][2], B1[2][2];
    const char* cA = (const char*)g.A + (size_t)cur.pm * tstep; const char* cB = (const char*)g.Bt + (size_t)cur.pn * tstep;
    S.a_ready(cur);
    if constexpr (SP2) {
        PG8_STAGE(PG8_SB(0, 0), cB, voffB); PG8_STAGE(PG8_SB(0, 1), cB + hstep, voffB); PG8_STAGE(PG8_SA(0, 0), cA, voffA); PG8_STAGE(PG8_SA(0, 1), cA + hstep, voffA);
        if (wr == 1) PG8_BAR;
        PG8_WAIT_V(2); PG8_BAR;
        PG8_STAGE(PG8_SB(1, 0), cB + kstep, voffB); PG8_STAGE(PG8_SA(1, 0), cA + kstep, voffA); PG8_STAGE(PG8_SB(1, 1), cB + hstep + kstep, voffB);
        PG8_WAIT_V(6); PG8_BAR;
    } else {
        PG8_STAGE(PG8_SB(0, 0), cB, voffB); PG8_STAGE(PG8_SA(0, 0), cA, voffA); PG8_STAGE(PG8_SB(0, 1), cB + hstep, voffB); PG8_STAGE(PG8_SA(0, 1), cA + hstep, voffA);
        if (wr == 1) PG8_BAR;
        PG8_WAIT_V(4); PG8_BAR;
        PG8_STAGE(PG8_SB(1, 0), cB + kstep, voffB); PG8_STAGE(PG8_SA(1, 0), cA + kstep, voffA); PG8_STAGE(PG8_SB(1, 1), cB + hstep + kstep, voffB);
        PG8_WAIT_V(6); PG8_BAR;
    }
    for (;;) {
        const bool has_next = S.next(ui + 1, nxt);
        const char* nA = has_next ? (const char*)g.A + (size_t)nxt.pm * tstep : cA; const char* nB = has_next ? (const char*)g.Bt + (size_t)nxt.pn * tstep : cB;
        for (int t = 0; t < nt; t += 2) {
            const bool last = (t == nt - 2);
            const char* a1 = cA + (size_t)(t + 1) * kstep;
            const char* a2 = last ? nA : cA + (size_t)(t + 2) * kstep; const char* b2 = last ? nB : cB + (size_t)(t + 2) * kstep;
            const char* a3 = a2 + kstep; const char* b3 = b2 + kstep;
            if (last && has_next) S.a_ready(nxt);
            if constexpr (SP2) {
            PG8_LDB(B0, 0, 0); PG8_LDB(B1, 0, 1); PG8_SCHED; PG8_LDA(At, 0, 0); PG8_STAGE(PG8_SA(1, 1), a1 + hstep, voffA);
            PG8_WAIT_V(8); PG8_WAIT_L(0); PG8_BAR; PG8_MMA(0, 0, At, B0); PG8_MMA(0, 1, At, B1); PG8_BAR; PG8_SCHED;
            PG8_LDA(At, 0, 1); PG8_STAGE(PG8_SB(0, 0), b2, voffB); PG8_STAGE(PG8_SB(0, 1), b2 + hstep, voffB); PG8_STAGE(PG8_SA(0, 0), a2, voffA);
            PG8_WAIT_V(8); PG8_WAIT_L(0); PG8_BAR; PG8_MMA(1, 0, At, B0); PG8_MMA(1, 1, At, B1); PG8_BAR; PG8_SCHED;
            PG8_LDB(B0, 1, 0); PG8_LDB(B1, 1, 1); PG8_SCHED; PG8_LDA(At, 1, 0); PG8_STAGE(PG8_SA(0, 1), a2 + hstep, voffA);
            PG8_WAIT_V(8); PG8_WAIT_L(0); PG8_BAR; PG8_MMA(0, 0, At, B0); PG8_MMA(0, 1, At, B1); PG8_BAR; PG8_SCHED;
            PG8_LDA(At, 1, 1); PG8_STAGE(PG8_SB(1, 0), b3, voffB); PG8_STAGE(PG8_SB(1, 1), b3 + hstep, voffB); PG8_STAGE(PG8_SA(1, 0), a3, voffA);
            PG8_WAIT_V(8); PG8_WAIT_L(0); PG8_BAR; PG8_MMA(1, 0, At, B0); PG8_MMA(1, 1, At, B1); PG8_BAR; PG8_SCHED;
            } else {
            PG8_LDB(B0, 0, 0); PG8_SCHED; PG8_LDA(At, 0, 0); PG8_STAGE(PG8_SA(1, 1), a1 + hstep, voffA);
            PG8_WAIT_L(8); PG8_BAR; PG8_WAIT_L(0); PG8_MMA(0, 0, At, B0); PG8_BAR; PG8_SCHED;
            PG8_LDB(B1, 0, 1); PG8_STAGE(PG8_SB(0, 0), b2, voffB);
            PG8_BAR; PG8_WAIT_L(0); PG8_MMA(0, 1, At, B1); PG8_BAR;
            PG8_LDA(At, 0, 1); PG8_STAGE(PG8_SA(0, 0), a2, voffA);
            PG8_BAR; PG8_WAIT_L(0); PG8_MMA(1, 0, At, B0); PG8_BAR; PG8_SCHED;
            PG8_STAGE(PG8_SB(0, 1), b2 + hstep, voffB);
            PG8_WAIT_V(6); PG8_BAR; PG8_MMA(1, 1, At, B1); PG8_BAR;
            PG8_LDB(B0, 1, 0); PG8_SCHED; PG8_LDA(At, 1, 0); PG8_STAGE(PG8_SA(0, 1), a2 + hstep, voffA);
            PG8_WAIT_L(8); PG8_BAR; PG8_WAIT_L(0); PG8_MMA(0, 0, At, B0); PG8_BAR; PG8_SCHED;
            PG8_LDB(B1, 1, 1); PG8_STAGE(PG8_SB(1, 0), b3, voffB);
            PG8_BAR; PG8_WAIT_L(0); PG8_MMA(0, 1, At, B1); PG8_BAR;
            PG8_LDA(At, 1, 1); PG8_STAGE(PG8_SA(1, 0), a3, voffA);
            PG8_BAR; PG8_WAIT_L(0); PG8_MMA(1, 0, At, B0); PG8_BAR; PG8_SCHED;
            PG8_STAGE(PG8_SB(1, 1), b3 + hstep, voffB);
            PG8_WAIT_V(6); PG8_BAR; PG8_MMA(1, 1, At, B1); PG8_BAR;
            }
        }
        if constexpr (ALIGN_EPI) { if (wr == 0) PG8_BAR; }
        if constexpr (!Epi::AFTER_DRAIN) { E(acc, cur, wr, wc, fr, fq); S.done(cur); }
        if (!has_next) break;
#pragma unroll
        for (int a = 0; a < 2; ++a)
#pragma unroll
            for (int b = 0; b < 2; ++b)
#pragma unroll
                for (int m = 0; m < 4; ++m)
#pragma unroll
                    for (int n = 0; n < 2; ++n) acc[a][b][m][n] = (f32x4){0.f, 0.f, 0.f, 0.f};
        cur = nxt; cA = nA; cB = nB; ++ui;
        if constexpr (ALIGN_EPI) { if (wr == 1) PG8_BAR; }
    }
    PG8_WAIT_V(0);
    if constexpr (!ALIGN_EPI) { if (wr == 0) PG8_BAR; }
    PG8_BAR;
    if constexpr (Epi::AFTER_DRAIN) { E.fused(acc, cur, wr, wc, fr, fq, lds, wid, lane); S.done(cur); }
#undef PG8_SA
#undef PG8_SB
#undef PG8_STAGE
#undef PG8_LDA
#undef PG8_LDB
#undef PG8_MMA
#undef PG8_WAIT_V
#undef PG8_WAIT_L
#undef PG8_BAR
#undef PG8_SCHED
}
}

#define LAS __attribute__((address_space(3)))
typedef unsigned short bf16;
typedef unsigned v4u __attribute__((ext_vector_type(4)));
typedef float f32x4 __attribute__((ext_vector_type(4)));
typedef float f32x2 __attribute__((ext_vector_type(2)));
typedef float f32x16 __attribute__((ext_vector_type(16)));
typedef short bf16x8 __attribute__((ext_vector_type(8)));

constexpr int TT = 16384, DM = 2048, SEQ = 4096, NH = 8;
constexpr int INC = 11280;
constexpr int NP = 11264;
constexpr int DFF = 5632;
constexpr int C_MK = 1024, C_MV = 2048, C_DQ = 3072, C_DZ = 6144, C_GA = 7168, C_GB = 9216;
constexpr float EPS = 1e-6f;
constexpr float QSCALE = 0.08838834764831845f;
constexpr float QSCALE_L2E = 0.08838834764831845f * 1.4426950408889634f;

constexpr size_t MiB = 1u << 20;
constexpr size_t WS_W = 1 * MiB, WS_P = 128 * MiB, WS_R = 480 * MiB, WS_BG = 672 * MiB, WS_KM = 673 * MiB, WS_END = 674 * MiB;
constexpr size_t W_IN = 0, W_A = 23068672, W_B = 25165824, W_O = 27262976, W_FI = 31457280, W_FD = 54525952, W_BA = 66060288;
constexpr size_t R_H = 0, R_YA = 64 * MiB, R_YB = 96 * MiB, R_MG = 128 * MiB, R_ACT = 0, R_DQ = 0, R_DK = 32 * MiB, R_DV = 128 * MiB, R_TB = 160 * MiB, R_AB = 176 * MiB;

constexpr int NPH = 11;
constexpr int LDS_BYTES = 147456;

__device__ __forceinline__ unsigned f2bf(float f) { unsigned u = __builtin_bit_cast(unsigned, f); return (u + 0x7fffu + ((u >> 16) & 1u)) >> 16; }
__device__ __forceinline__ unsigned pk2(float lo, float hi) { return f2bf(lo) | (f2bf(hi) << 16); }
__device__ __forceinline__ float bflo(unsigned u) { return __uint_as_float(u << 16); }
__device__ __forceinline__ float bfhi(unsigned u) { return __uint_as_float(u & 0xffff0000u); }
__device__ __forceinline__ float bf1(bf16 h) { return __uint_as_float(((unsigned)h) << 16); }
__device__ __forceinline__ float wave_sum(float v) {
#pragma unroll
    for (int o = 1; o < 64; o <<= 1) v += __shfl_xor(v, o);
    return v;
}
__device__ __forceinline__ float siluf_(float x) { return x * __builtin_amdgcn_rcpf(1.f + __expf(-x)); }
__device__ __forceinline__ int crow(int reg, int h) { return (reg & 3) + 8 * (reg >> 2) + 4 * h; }

typedef short s16x4 __attribute__((ext_vector_type(4)));
typedef short v4i16_t __attribute__((ext_vector_type(4)));
__device__ __forceinline__ s16x4 tr_read(LAS const unsigned char* p) { return __builtin_bit_cast(s16x4, __builtin_amdgcn_ds_read_tr16_b64_v4i16((LAS v4i16_t*)p)); }
__device__ __forceinline__ float bfs(short h) { return __uint_as_float(((unsigned)(unsigned short)h) << 16); }
typedef float f32x2_t __attribute__((ext_vector_type(2)));
typedef __bf16 bf16x2_t __attribute__((ext_vector_type(2)));
__device__ __forceinline__ unsigned cvtpk(float lo, float hi) { f32x2_t v = {lo, hi}; bf16x2_t b = __builtin_convertvector(v, bf16x2_t); return __builtin_bit_cast(unsigned, b); }

__device__ __forceinline__ void moba_item(LAS unsigned char* lds, const bf16* P, const float* KM, bf16* YA, int b, int h, int qb, int tid, int lane, int wave) {
    const int r = lane & 31, hh = lane >> 5;
    const size_t rowb = (size_t)b * SEQ;
    const int qin = 32 * wave + r;
    bf16x8 qf[8];
    { const bf16* qp = P + (rowb + qb * 256 + qin) * NP + h * 128 + 8 * hh;
#pragma unroll
      for (int st = 0; st < 8; ++st) qf[st] = *(const bf16x8*)(qp + 16 * st); }
    unsigned sel;
    if (qb <= 3) sel = (1u << qb) - 1u;
    else {
        float g1 = -INFINITY, g2 = -INFINITY, g3 = -INFINITY; int i1 = 0, i2 = 0, i3 = 0;
        for (int n = 0; n < qb; ++n) {
            const float* km = KM + ((size_t)(b * 8 + h) * 16 + n) * 128 + 8 * hh;
            float gs = 0.f;
#pragma unroll
            for (int st = 0; st < 8; ++st) { const f32x4 m0 = *(const f32x4*)(km + 16 * st), m1 = *(const f32x4*)(km + 16 * st + 4);
                gs += bfs(qf[st][0]) * m0.x + bfs(qf[st][1]) * m0.y + bfs(qf[st][2]) * m0.z + bfs(qf[st][3]) * m0.w
                    + bfs(qf[st][4]) * m1.x + bfs(qf[st][5]) * m1.y + bfs(qf[st][6]) * m1.z + bfs(qf[st][7]) * m1.w; }
            gs += __shfl_xor(gs, 32);
            if (gs > g1) { g3 = g2; i3 = i2; g2 = g1; i2 = i1; g1 = gs; i1 = n; }
            else if (gs > g2) { g3 = g2; i3 = i2; g2 = gs; i2 = n; }
            else if (gs > g3) { g3 = gs; i3 = n; }
        }
        sel = (1u << i1) | (1u << i2) | (1u << i3);
    }
    f32x16 o[4];
#pragma unroll
    for (int d = 0; d < 4; ++d)
#pragma unroll
        for (int i = 0; i < 16; ++i) o[d][i] = 0.f;
    float lsum = 0.f;
    const int key0 = tid >> 4, ch = tid & 15;
    const unsigned soff = (unsigned)(key0 * 256 + ((ch ^ (key0 & 15)) << 4));
    const bf16* gk = P + (rowb + key0) * NP + C_MK + h * 128 + 8 * ch;
    const int nt = 4 * qb + 4;
    v4u kr0, kr1, vr0, vr1;
    kr0 = *(const v4u*)gk; kr1 = *(const v4u*)(gk + (size_t)32 * NP); vr0 = *(const v4u*)(gk + 1024); vr1 = *(const v4u*)(gk + (size_t)32 * NP + 1024);
    *(LAS v4u*)(lds + soff) = kr0; *(LAS v4u*)(lds + soff + 8192) = kr1; *(LAS v4u*)(lds + 32768 + soff) = vr0; *(LAS v4u*)(lds + 32768 + soff + 8192) = vr1;
    __syncthreads();
    const unsigned kbase = (unsigned)(r * 256);
    const int q4 = (lane & 15) >> 2, p4 = lane & 3, grp = (lane >> 4) & 1;
    for (int t = 0; t < nt; ++t) {
        const int n = t >> 2, tt = t & 3; const bool own = (n == qb);
        const unsigned buf = (unsigned)(t & 1) * 16384u;
        if (t + 1 < nt) { const bf16* g2p = gk + (size_t)(t + 1) * 64 * NP;
            kr0 = *(const v4u*)g2p; kr1 = *(const v4u*)(g2p + (size_t)32 * NP); vr0 = *(const v4u*)(g2p + 1024); vr1 = *(const v4u*)(g2p + (size_t)32 * NP + 1024); }
        const bool mine = (sel >> n) & 1u;
        const bool active = own ? (64 * tt <= 32 * wave + 31) : (__ballot(mine) != 0ull);
        if (active) {
            f32x16 sT[2];
#pragma unroll
            for (int kt = 0; kt < 2; ++kt) {
#pragma unroll
                for (int i = 0; i < 16; ++i) sT[kt][i] = 0.f;
#pragma unroll
                for (int st = 0; st < 8; ++st) {
                    const bf16x8 kf = *(const LAS bf16x8*)(lds + buf + kbase + kt * 8192 + (((2 * st + hh) ^ (r & 15)) << 4));
                    sT[kt] = __builtin_amdgcn_mfma_f32_32x32x16_bf16(kf, qf[st], sT[kt], 0, 0, 0);
                }
            }
            bf16x8 pf[2][2];
#pragma unroll
            for (int kt = 0; kt < 2; ++kt) {
#pragma unroll
                for (int i = 0; i < 16; ++i) {
                    const int key = 64 * tt + 32 * kt + crow(i, hh);
                    const bool ok = own ? (key <= qin) : mine;
                    const float pv = ok ? __builtin_amdgcn_exp2f(sT[kt][i]) : 0.f;
                    lsum += pv; sT[kt][i] = pv;
                }
#pragma unroll
                for (int s = 0; s < 2; ++s) { v4u w; w.x = cvtpk(sT[kt][8 * s], sT[kt][8 * s + 1]); w.y = cvtpk(sT[kt][8 * s + 2], sT[kt][8 * s + 3]);
                    w.z = cvtpk(sT[kt][8 * s + 4], sT[kt][8 * s + 5]); w.w = cvtpk(sT[kt][8 * s + 6], sT[kt][8 * s + 7]); pf[kt][s] = __builtin_bit_cast(bf16x8, w); }
            }
#pragma unroll
            for (int dt = 0; dt < 4; ++dt) {
                const int chunk = 4 * dt + 2 * grp + (p4 >> 1);
#pragma unroll
                for (int kt = 0; kt < 2; ++kt)
#pragma unroll
                    for (int s = 0; s < 2; ++s) {
                        const int klo = 32 * kt + 16 * s + 4 * hh + q4, khi = klo + 8;
                        const s16x4 lo = tr_read(lds + 32768 + buf + klo * 256 + ((chunk ^ (klo & 15)) << 4) + 8 * (p4 & 1));
                        const s16x4 hi = tr_read(lds + 32768 + buf + khi * 256 + ((chunk ^ (khi & 15)) << 4) + 8 * (p4 & 1));
                        const bf16x8 vf = __builtin_shufflevector(lo, hi, 0, 1, 2, 3, 4, 5, 6, 7);
                        o[dt] = __builtin_amdgcn_mfma_f32_32x32x16_bf16(vf, pf[kt][s], o[dt], 0, 0, 0);
                    }
            }
        }
        if (t + 1 < nt) { const unsigned nb = (unsigned)((t + 1) & 1) * 16384u;
            *(LAS v4u*)(lds + nb + soff) = kr0; *(LAS v4u*)(lds + nb + soff + 8192) = kr1; *(LAS v4u*)(lds + 32768 + nb + soff) = vr0; *(LAS v4u*)(lds + 32768 + nb + soff + 8192) = vr1; }
        __syncthreads();
    }
    lsum += __shfl_xor(lsum, 32);
    const float inv = 1.f / lsum;
    bf16* yp = YA + (rowb + qb * 256 + qin) * 1024 + h * 128 + 4 * hh;
#pragma unroll
    for (int dt = 0; dt < 4; ++dt)
#pragma unroll
        for (int g = 0; g < 4; ++g) {
            unsigned long long w = (unsigned long long)cvtpk(o[dt][4 * g] * inv, o[dt][4 * g + 1] * inv) | ((unsigned long long)cvtpk(o[dt][4 * g + 2] * inv, o[dt][4 * g + 3] * inv) << 32);
            *(unsigned long long*)(yp + 32 * dt + 8 * g) = w;
        }
}

typedef unsigned v2u __attribute__((ext_vector_type(2)));
#define LBAR() do { asm volatile("s_waitcnt lgkmcnt(0)" ::: "memory"); __builtin_amdgcn_s_barrier(); asm volatile("" ::: "memory"); } while (0)
__device__ __forceinline__ int perm16(int o) { const int pc = o >> 2; return (o & 3) + 4 * ((pc == 1) ? 2 : ((pc == 2) ? 1 : pc)); }
template <int CTRL> __device__ __forceinline__ float dppf(float v) { return __builtin_bit_cast(float, __builtin_amdgcn_update_dpp(0, __builtin_bit_cast(int, v), CTRL, 0xf, 0xf, true)); }
__device__ __forceinline__ float bfe(const v4u& v, int e) { return (e & 1) ? bfhi(v[e >> 1]) : bflo(v[e >> 1]); }
__device__ __forceinline__ bf16x8 comb(v2u lo, v2u hi) { v4u w; w.x = lo.x; w.y = lo.y; w.z = hi.x; w.w = hi.y; return __builtin_bit_cast(bf16x8, w); }
__device__ __forceinline__ bf16x8 pack8(const f32x16& x, int s) { v4u w; w.x = cvtpk(x[8 * s], x[8 * s + 1]); w.y = cvtpk(x[8 * s + 2], x[8 * s + 3]); w.z = cvtpk(x[8 * s + 4], x[8 * s + 5]); w.w = cvtpk(x[8 * s + 6], x[8 * s + 7]); return __builtin_bit_cast(bf16x8, w); }

constexpr int DP_K = 4096, DP_Q = DP_K + 16384, DP_G = DP_Q + 16384, DP_B = DP_G + 256, DP_L = DP_B + 256, DP_T = DP_L + 16384, DP_A = DP_T + 8192, DP_W = DP_A + 8192;
__device__ __forceinline__ void dn_prep_phase(LAS unsigned char* lds, const bf16* P, const float* cw, bf16* DQ, bf16* DK, bf16* DV, const float* BETA, float* GG, bf16* TB, bf16* AB,
                                              int G, int tid0, int wave) {
    v4u raw[3][5]; float wpre[3]; float gpre = 0.f, bpre = 0.f;
#define DP_PREFETCH(item) do { const int b_ = (item) >> 9, h_ = ((item) >> 6) & 7, c_ = (item) & 63; const size_t rowb_ = (size_t)b_ * SEQ + c_ * 64; \
        int t_ = tid0; asm volatile("" : "+v"(t_)); const int rg_ = t_ >> 4, ch_ = t_ & 15, s0_ = c_ * 64 + 2 * rg_; \
        _Pragma("unroll") for (int x = 0; x < 3; ++x) _Pragma("unroll") for (int i = 0; i < 5; ++i) { \
            if (s0_ - 3 + i >= 0) raw[x][i] = *(const v4u*)(P + (rowb_ + 2 * rg_ + i - 3) * NP + C_DQ + x * 1024 + h_ * 128 + 8 * ch_); else raw[x][i] = (v4u){0u, 0u, 0u, 0u}; } \
        _Pragma("unroll") for (int j = 0; j < 3; ++j) { const int e = t_ + 512 * j, x = e >> 9, i = (e >> 7) & 3, d = e & 127; wpre[j] = cw[i * 3072 + x * 1024 + h_ * 128 + d]; } \
        if (wave == 0) { gpre = GG[(rowb_ + (t_ & 63)) * 8 + h_]; bpre = BETA[(rowb_ + (t_ & 63)) * 8 + h_]; } } while (0)
    int item = blockIdx.x;
    if (item < 2048) DP_PREFETCH(item);
    for (; item < 2048; item += G) {
        int tid = tid0; asm volatile("" : "+v"(tid));
        const int lane = tid & 63;
        const int b = item >> 9, h = (item >> 6) & 7, c = item & 63;
        const size_t rowb = (size_t)b * SEQ + c * 64;
#pragma unroll
        for (int j = 0; j < 3; ++j) ((LAS float*)(lds + DP_W))[tid + 512 * j] = wpre[j];
        LBAR();
        {
            const int rg = tid >> 4, ch = tid & 15;
#pragma unroll
            for (int x = 0; x < 3; ++x) {
                float a0[8], a1[8];
#pragma unroll
                for (int e = 0; e < 8; ++e) { a0[e] = 0.f; a1[e] = 0.f; }
#pragma unroll
                for (int i = 0; i < 4; ++i) { const LAS float* wp = (const LAS float*)(lds + DP_W) + (x * 4 + i) * 128 + 8 * ch; const f32x4 w0 = *(const LAS f32x4*)wp, w1 = *(const LAS f32x4*)(wp + 4);
#pragma unroll
                    for (int e = 0; e < 8; ++e) { const float wv = (e < 4) ? w0[e & 3] : w1[e & 3]; a0[e] += wv * bfe(raw[x][i], e); a1[e] += wv * bfe(raw[x][i + 1], e); } }
                float ss0 = 0.f, ss1 = 0.f;
#pragma unroll
                for (int e = 0; e < 8; ++e) { a0[e] = siluf_(a0[e]); a1[e] = siluf_(a1[e]); ss0 += a0[e] * a0[e]; ss1 += a1[e] * a1[e]; }
                if (x < 2) {
                    ss0 += dppf<0xB1>(ss0); ss1 += dppf<0xB1>(ss1); ss0 += dppf<0x4E>(ss0); ss1 += dppf<0x4E>(ss1);
                    ss0 += dppf<0x141>(ss0); ss1 += dppf<0x141>(ss1); ss0 += dppf<0x140>(ss0); ss1 += dppf<0x140>(ss1);
                    const float r0 = rsqrtf(ss0 + EPS) * (x == 0 ? QSCALE : 1.f), r1 = rsqrtf(ss1 + EPS) * (x == 0 ? QSCALE : 1.f);
#pragma unroll
                    for (int e = 0; e < 8; ++e) { a0[e] *= r0; a1[e] *= r1; }
                }
                v4u o0, o1;
                o0.x = cvtpk(a0[0], a0[1]); o0.y = cvtpk(a0[2], a0[3]); o0.z = cvtpk(a0[4], a0[5]); o0.w = cvtpk(a0[6], a0[7]);
                o1.x = cvtpk(a1[0], a1[1]); o1.y = cvtpk(a1[2], a1[3]); o1.z = cvtpk(a1[4], a1[5]); o1.w = cvtpk(a1[6], a1[7]);
                bf16* dst = (x == 0 ? DQ : (x == 1 ? DK : DV)) + (rowb + 2 * rg) * 1024 + h * 128 + 8 * ch;
                *(v4u*)dst = o0; *(v4u*)(dst + 1024) = o1;
                if (x < 2) { LAS unsigned char* base = lds + (x == 0 ? DP_Q : DP_K); const int row = 2 * rg;
                    *(LAS v4u*)(base + row * 256 + ((ch ^ (row & 15)) << 4)) = o0; *(LAS v4u*)(base + (row + 1) * 256 + ((ch ^ ((row + 1) & 15)) << 4)) = o1; }
            }
        }
        if (wave == 0) {
            float g = gpre;
#pragma unroll
            for (int d = 1; d < 64; d <<= 1) { const float v = __shfl_up(g, d); if (lane >= d) g += v; }
            GG[(rowb + lane) * 8 + h] = g; ((LAS float*)(lds + DP_G))[lane] = g; ((LAS float*)(lds + DP_B))[lane] = bpre;
        }
        if (item + G < 2048) DP_PREFETCH(item + G);
        LBAR();
        {
            const int r = lane & 31, hh = lane >> 5;
            const LAS float* Gs = (const LAS float*)(lds + DP_G); const LAS float* Bs = (const LAS float*)(lds + DP_B);
            LAS float* Ls = (LAS float*)(lds + DP_L); LAS bf16* As = (LAS bf16*)(lds + DP_A);
            if (wave < 6) {
                const int prod = wave / 3, tl = wave % 3, ti = (tl >= 1) ? 1 : 0, tj = (tl == 2) ? 1 : 0;
                const LAS unsigned char* Ab = lds + (prod == 0 ? DP_K : DP_Q) + (32 * ti + r) * 256; const LAS unsigned char* Bb = lds + DP_K + (32 * tj + r) * 256;
                f32x16 acc;
#pragma unroll
                for (int i = 0; i < 16; ++i) acc[i] = 0.f;
#pragma unroll
                for (int st = 0; st < 8; ++st) { const int sw = ((2 * st + hh) ^ (r & 15)) << 4;
                    acc = __builtin_amdgcn_mfma_f32_32x32x16_bf16(*(const LAS bf16x8*)(Ab + sw), *(const LAS bf16x8*)(Bb + sw), acc, 0, 0, 0); }
                const int j = 32 * tj + r; const float Gj = Gs[j];
#pragma unroll
                for (int idx = 0; idx < 16; ++idx) { const int i = 32 * ti + crow(idx, hh); const float dec = __expf(Gs[i] - Gj);
                    if (prod == 0) Ls[i * 64 + (j & 7) * 8 + (j >> 3)] = (i > j) ? Bs[i] * acc[idx] * dec : 0.f;
                    else As[i * 64 + (j & 48) + perm16(j & 15)] = (bf16)((i >= j) ? f2bf(acc[idx] * dec) : 0u); }
            } else if (wave == 6) {
#pragma unroll
                for (int e = 0; e < 4; ++e) { const int id = lane + 64 * e, i = id >> 3, q8 = id & 7; *(LAS f32x4*)(Ls + i * 64 + q8 * 8 + 4) = (f32x4){0.f, 0.f, 0.f, 0.f}; }
            } else {
#pragma unroll
                for (int e = 0; e < 8; ++e) *(LAS v4u*)(lds + DP_T + (lane + 64 * e) * 16) = (v4u){0u, 0u, 0u, 0u};
#pragma unroll
                for (int e = 0; e < 2; ++e) { const int id = lane + 64 * e, i = id >> 2, c4 = id & 3; *(LAS v4u*)(lds + DP_A + i * 128 + 64 + c4 * 16) = (v4u){0u, 0u, 0u, 0u}; }
            }
        }
        LBAR();
        {
            const int cl = lane >> 3, q8 = lane & 7, col = 8 * wave + cl;
            float xs[8];
#pragma unroll
            for (int k = 0; k < 8; ++k) xs[k] = 0.f;
            const LAS float* Lp = (const LAS float*)(lds + DP_L) + q8 * 8;
            LAS bf16* Ts = (LAS bf16*)(lds + DP_T);
#pragma unroll
            for (int i = 0; i < 64; ++i) {
                if (i >= 8 * wave) {
                    const f32x4 l0 = *(const LAS f32x4*)(Lp + i * 64), l1 = *(const LAS f32x4*)(Lp + i * 64 + 4);
                    float s = 0.f;
#pragma unroll
                    for (int kk = 0; kk < 8; ++kk) if (8 * kk < i) s += ((kk < 4) ? l0[kk & 3] : l1[kk & 3]) * xs[kk];
                    s += dppf<0xB1>(s); s += dppf<0x4E>(s); s += dppf<0x141>(s);
                    const float xi = ((i == col) ? 1.f : 0.f) - s;
                    if ((i & 7) == q8) { xs[i >> 3] = xi; Ts[i * 64 + (col & 48) + perm16(col & 15)] = (bf16)f2bf(xi); }
                }
            }
        }
        LBAR();
        { const size_t ib = (((size_t)(b * 8 + h)) * 64 + c) * 4096;
          *(v4u*)(TB + ib + tid * 8) = *(const LAS v4u*)(lds + DP_T + tid * 16); *(v4u*)(AB + ib + tid * 8) = *(const LAS v4u*)(lds + DP_A + tid * 16); }
    }
    LBAR();
#undef DP_PREFETCH
}

constexpr int SQ_K = 0, SQ_Q = 16384, SQ_V = 32768, SQ_T = 49152, SQ_A = 58368, SQ_EG = 67584, SQ_ED = 67904, SQ_BT = 68160, SQ_SZ = 68416;
__device__ __forceinline__ void dn_seq(LAS unsigned char* lds, const bf16* P, const bf16* DQ, const bf16* DK, const bf16* DV, const float* BETA, const float* GG, const bf16* TB, const bf16* AB,
                                       bf16* YB, const float* og, int b, int h, int tid, int lane, int wave) {
    const size_t rowb = (size_t)b * SEQ;
    const size_t ibh = ((size_t)(b * 8 + h)) * 64 * 4096;
    if (wave >= 4) {
        int lt = tid - 256;
        v4u rk[4], rq[4], rv[4], rt[2], ra[2]; float gG = 0.f, gB = 0.f;
#define DN_LOAD(c) do { asm volatile("" : "+v"(lt)); \
        _Pragma("unroll") for (int i = 0; i < 4; ++i) { const int e = lt + 256 * i, row = e >> 4, ch = e & 15; const size_t go = (rowb + (size_t)(c) * 64 + row) * 1024 + h * 128 + 8 * ch; \
            rk[i] = *(const v4u*)(DK + go); rq[i] = *(const v4u*)(DQ + go); rv[i] = *(const v4u*)(DV + go); } \
        _Pragma("unroll") for (int i = 0; i < 2; ++i) { const int e = lt + 256 * i; rt[i] = *(const v4u*)(TB + ibh + (size_t)(c) * 4096 + e * 8); ra[i] = *(const v4u*)(AB + ibh + (size_t)(c) * 4096 + e * 8); } \
        if (wave == 4) { gG = GG[(rowb + (size_t)(c) * 64 + lane) * 8 + h]; gB = BETA[(rowb + (size_t)(c) * 64 + lane) * 8 + h]; } } while (0)
#define DN_STORE(buf) do { asm volatile("" : "+v"(lt)); LAS unsigned char* bb = lds + (buf) * SQ_SZ; \
        _Pragma("unroll") for (int i = 0; i < 4; ++i) { const int e = lt + 256 * i, row = e >> 4, ch = e & 15; const int sw = row * 256 + ((ch ^ (row & 15)) << 4); \
            *(LAS v4u*)(bb + SQ_K + sw) = rk[i]; *(LAS v4u*)(bb + SQ_Q + sw) = rq[i]; *(LAS v4u*)(bb + SQ_V + row * 256 + ch * 16) = rv[i]; } \
        _Pragma("unroll") for (int i = 0; i < 2; ++i) { const int e = lt + 256 * i, row = e >> 3, c8 = e & 7; *(LAS v4u*)(bb + SQ_T + row * 144 + c8 * 16) = rt[i]; *(LAS v4u*)(bb + SQ_A + row * 144 + c8 * 16) = ra[i]; } \
        if (wave == 4) { const float gl = __shfl(gG, 63); ((LAS float*)(bb + SQ_EG))[lane] = __expf(gG); ((LAS float*)(bb + SQ_ED))[lane] = __expf(gl - gG); ((LAS float*)(bb + SQ_BT))[lane] = gB; \
            if (lane == 63) ((LAS float*)(bb + SQ_EG))[64] = __expf(gl); } } while (0)
        DN_LOAD(0); DN_STORE(0); DN_LOAD(1);
        LBAR();
        for (int c = 0; c < 64; ++c) {
            if (c + 1 < 64) { DN_STORE((c + 1) & 1); if (c + 2 < 64) DN_LOAD(c + 2); }
            asm volatile("" : "+v"(lt));
            const int orow = lt >> 2, oq = lt & 3;
            const size_t grow = rowb + (size_t)c * 64 + orow;
            v4u zr[4];
#pragma unroll
            for (int j = 0; j < 4; ++j) zr[j] = *(const v4u*)(P + grow * NP + C_DZ + h * 128 + 32 * oq + 8 * j);
            LBAR();
            {
                const LAS unsigned char* ob = lds + (c & 1) * SQ_SZ + SQ_V + orow * 256 + 64 * oq;
                v4u ov[4]; float ss = 0.f;
#pragma unroll
                for (int j = 0; j < 4; ++j) { ov[j] = *(const LAS v4u*)(ob + 16 * j);
#pragma unroll
                    for (int e = 0; e < 4; ++e) { const float x0 = bflo(ov[j][e]), x1 = bfhi(ov[j][e]); ss += x0 * x0 + x1 * x1; } }
                ss += dppf<0xB1>(ss); ss += dppf<0x4E>(ss);
                const float rinv = rsqrtf(ss * (1.f / 128) + EPS);
                bf16* yp = YB + grow * 1024 + h * 128 + 32 * oq;
#pragma unroll
                for (int j = 0; j < 4; ++j) { const f32x4 ga = *(const f32x4*)(og + 32 * oq + 8 * j), gb = *(const f32x4*)(og + 32 * oq + 8 * j + 4);
                    v4u w;
                    w.x = pk2(bflo(ov[j].x) * rinv * ga.x * siluf_(bflo(zr[j].x)), bfhi(ov[j].x) * rinv * ga.y * siluf_(bfhi(zr[j].x)));
                    w.y = pk2(bflo(ov[j].y) * rinv * ga.z * siluf_(bflo(zr[j].y)), bfhi(ov[j].y) * rinv * ga.w * siluf_(bfhi(zr[j].y)));
                    w.z = pk2(bflo(ov[j].z) * rinv * gb.x * siluf_(bflo(zr[j].z)), bfhi(ov[j].z) * rinv * gb.y * siluf_(bfhi(zr[j].z)));
                    w.w = pk2(bflo(ov[j].w) * rinv * gb.z * siluf_(bflo(zr[j].w)), bfhi(ov[j].w) * rinv * gb.w * siluf_(bfhi(zr[j].w)));
                    *(v4u*)(yp + 8 * j) = w; }
            }
            LBAR();
        }
#undef DN_LOAD
#undef DN_STORE
    } else {
        const int w = wave;
        f32x16 S[4];
#pragma unroll
        for (int kt = 0; kt < 4; ++kt)
#pragma unroll
            for (int i = 0; i < 16; ++i) S[kt][i] = 0.f;
        LBAR();
        for (int c = 0; c < 64; ++c) {
            int ln = lane; asm volatile("" : "+v"(ln));
            const int r = ln & 31, hh = ln >> 5, q4 = (ln & 15) >> 2, p4 = ln & 3, grp = (ln >> 4) & 1;
            const LAS unsigned char* bb = lds + (c & 1) * SQ_SZ;
            const LAS float* EG = (const LAS float*)(bb + SQ_EG); const LAS float* ED = (const LAS float*)(bb + SQ_ED); const LAS float* BT = (const LAS float*)(bb + SQ_BT);
            f32x16 ks[2], qs[2];
#pragma unroll
            for (int ti = 0; ti < 2; ++ti)
#pragma unroll
                for (int i = 0; i < 16; ++i) { ks[ti][i] = 0.f; qs[ti][i] = 0.f; }
            {
                const LAS unsigned char* kr0 = bb + SQ_K + r * 256; const LAS unsigned char* qr0 = bb + SQ_Q + r * 256;
                bf16x8 ka0, ka1, qa0, qa1;
                { const int off = ((0 + hh) ^ (r & 15)) << 4; ka0 = *(const LAS bf16x8*)(kr0 + off); ka1 = *(const LAS bf16x8*)(kr0 + 8192 + off); qa0 = *(const LAS bf16x8*)(qr0 + off); qa1 = *(const LAS bf16x8*)(qr0 + 8192 + off); }
#pragma unroll
                for (int it = 0; it < 8; ++it) {
                    bf16x8 kb0 = ka0, kb1 = ka1, qb0 = qa0, qb1 = qa1;
                    if (it < 7) { const int off = ((2 * (it + 1) + hh) ^ (r & 15)) << 4; kb0 = *(const LAS bf16x8*)(kr0 + off); kb1 = *(const LAS bf16x8*)(kr0 + 8192 + off); qb0 = *(const LAS bf16x8*)(qr0 + off); qb1 = *(const LAS bf16x8*)(qr0 + 8192 + off); }
                    const bf16x8 sf = pack8(S[it >> 1], it & 1);
                    ks[0] = __builtin_amdgcn_mfma_f32_32x32x16_bf16(ka0, sf, ks[0], 0, 0, 0);
                    qs[0] = __builtin_amdgcn_mfma_f32_32x32x16_bf16(qa0, sf, qs[0], 0, 0, 0);
                    ks[1] = __builtin_amdgcn_mfma_f32_32x32x16_bf16(ka1, sf, ks[1], 0, 0, 0);
                    qs[1] = __builtin_amdgcn_mfma_f32_32x32x16_bf16(qa1, sf, qs[1], 0, 0, 0);
                    ka0 = kb0; ka1 = kb1; qa0 = qb0; qa1 = qb1;
                }
            }
#pragma unroll
            for (int ti = 0; ti < 2; ++ti)
#pragma unroll
                for (int g = 0; g < 4; ++g) { const int t0 = 32 * ti + 8 * g + 4 * hh;
                    const s16x4 vv = tr_read(bb + SQ_V + (t0 + q4) * 256 + (32 * w + 16 * grp + 4 * p4) * 2);
                    const f32x4 eg = *(const LAS f32x4*)(EG + t0), bt = *(const LAS f32x4*)(BT + t0);
#pragma unroll
                    for (int e = 0; e < 4; ++e) { const int i = 4 * g + e; ks[ti][i] = bt[e] * (bfs(vv[e]) - eg[e] * ks[ti][i]); qs[ti][i] = eg[e] * qs[ti][i]; } }
            f32x16 vn[2];
#pragma unroll
            for (int ti = 0; ti < 2; ++ti)
#pragma unroll
                for (int i = 0; i < 16; ++i) vn[ti][i] = 0.f;
            {
                bf16x8 rf[2][2];
#pragma unroll
                for (int tj = 0; tj < 2; ++tj)
#pragma unroll
                    for (int s = 0; s < 2; ++s) rf[tj][s] = pack8(ks[tj], s);
                const LAS unsigned char* tr0 = bb + SQ_T + r * 144 + 16 * hh;
                bf16x8 tf[6];
#pragma unroll
                for (int s = 0; s < 2; ++s) { tf[s] = *(const LAS bf16x8*)(tr0 + 32 * s); tf[2 + s] = *(const LAS bf16x8*)(tr0 + 32 * 144 + 32 * s); tf[4 + s] = *(const LAS bf16x8*)(tr0 + 32 * 144 + 64 + 32 * s); }
#pragma unroll
                for (int s = 0; s < 2; ++s) {
                    vn[0] = __builtin_amdgcn_mfma_f32_32x32x16_bf16(tf[s], rf[0][s], vn[0], 0, 0, 0);
                    vn[1] = __builtin_amdgcn_mfma_f32_32x32x16_bf16(tf[2 + s], rf[0][s], vn[1], 0, 0, 0); }
#pragma unroll
                for (int s = 0; s < 2; ++s) vn[1] = __builtin_amdgcn_mfma_f32_32x32x16_bf16(tf[4 + s], rf[1][s], vn[1], 0, 0, 0);
            }
            bf16x8 df[2][2];
            {
                bf16x8 vf[2][2];
#pragma unroll
                for (int tj = 0; tj < 2; ++tj)
#pragma unroll
                    for (int s = 0; s < 2; ++s) vf[tj][s] = pack8(vn[tj], s);
                const LAS unsigned char* ar0 = bb + SQ_A + r * 144 + 16 * hh;
                bf16x8 af[6];
#pragma unroll
                for (int s = 0; s < 2; ++s) { af[s] = *(const LAS bf16x8*)(ar0 + 32 * s); af[2 + s] = *(const LAS bf16x8*)(ar0 + 32 * 144 + 32 * s); af[4 + s] = *(const LAS bf16x8*)(ar0 + 32 * 144 + 64 + 32 * s); }
#pragma unroll
                for (int s = 0; s < 2; ++s) {
                    qs[0] = __builtin_amdgcn_mfma_f32_32x32x16_bf16(af[s], vf[0][s], qs[0], 0, 0, 0);
                    qs[1] = __builtin_amdgcn_mfma_f32_32x32x16_bf16(af[2 + s], vf[0][s], qs[1], 0, 0, 0); }
#pragma unroll
                for (int s = 0; s < 2; ++s) qs[1] = __builtin_amdgcn_mfma_f32_32x32x16_bf16(af[4 + s], vf[1][s], qs[1], 0, 0, 0);
#pragma unroll
                for (int ti = 0; ti < 2; ++ti)
#pragma unroll
                    for (int g = 0; g < 4; ++g) { const f32x4 ed = *(const LAS f32x4*)(ED + 32 * ti + 8 * g + 4 * hh);
#pragma unroll
                        for (int e = 0; e < 4; ++e) vn[ti][4 * g + e] *= ed[e]; }
#pragma unroll
                for (int tj = 0; tj < 2; ++tj)
#pragma unroll
                    for (int s = 0; s < 2; ++s) df[tj][s] = pack8(vn[tj], s);
            }
            {
                LAS bf16* op = (LAS bf16*)(lds + (c & 1) * SQ_SZ + SQ_V) + 32 * w + r;
#pragma unroll
                for (int ti = 0; ti < 2; ++ti)
#pragma unroll
                    for (int i = 0; i < 16; ++i) op[(32 * ti + crow(i, hh)) * 128] = (bf16)f2bf(qs[ti][i]);
            }
            LBAR();
            {
                const float egl = EG[64];
#pragma unroll
                for (int kt = 0; kt < 4; ++kt)
#pragma unroll
                    for (int i = 0; i < 16; ++i) S[kt][i] *= egl;
                const int pp = (p4 == 1) ? 2 : ((p4 == 2) ? 1 : p4);
                const int cb = 2 * grp + (pp >> 1), b8 = 8 * (pp & 1);
                s16x4 lo[4], hi[4];
#define DN_KT_LOAD(tj, s) do { const int klo = 32 * (tj) + 16 * (s) + 4 * hh + q4, khi = klo + 8; \
                _Pragma("unroll") for (int kt = 0; kt < 4; ++kt) { lo[kt] = tr_read(bb + SQ_K + klo * 256 + (((4 * kt + cb) ^ (klo & 15)) << 4) + b8); hi[kt] = tr_read(bb + SQ_K + khi * 256 + (((4 * kt + cb) ^ (khi & 15)) << 4) + b8); } } while (0)
                DN_KT_LOAD(0, 0);
#pragma unroll
                for (int it = 0; it < 4; ++it) {
                    bf16x8 kf[4];
#pragma unroll
                    for (int kt = 0; kt < 4; ++kt) kf[kt] = __builtin_shufflevector(lo[kt], hi[kt], 0, 1, 2, 3, 4, 5, 6, 7);
                    if (it < 3) DN_KT_LOAD((it + 1) >> 1, (it + 1) & 1);
#pragma unroll
                    for (int kt = 0; kt < 4; ++kt) S[kt] = __builtin_amdgcn_mfma_f32_32x32x16_bf16(kf[kt], df[it >> 1][it & 1], S[kt], 0, 0, 0);
                }
#undef DN_KT_LOAD
            }
            LBAR();
        }
    }
}

#define XB_TMO      128
#define XB_XCNT(j)  (256  + 64 * (j))
#define XB_XSUB(j)  (1280 + 64 * (j))
#define XB_XGEN(j)  (2304 + 64 * (j))
#define XB_TOP      3328
#define XB_TOPGEN   3392
#define XCD_BAR_WORDS 3456
#define XB_SPIN_CAP (1u << 18)

__device__ __forceinline__ unsigned xb_ld(unsigned* p)              { return __hip_atomic_load(p, __ATOMIC_RELAXED, __HIP_MEMORY_SCOPE_AGENT); }
__device__ __forceinline__ unsigned xb_add(unsigned* p, unsigned v) { return __hip_atomic_fetch_add(p, v, __ATOMIC_RELAXED, __HIP_MEMORY_SCOPE_AGENT); }
__device__ __forceinline__ unsigned xb_xcc_id() { return (unsigned)__builtin_amdgcn_s_getreg((3 << 11) | 20) & 0xFu; }
#define XB_SPIN(cond, bar) do { unsigned _sp = 0; while (cond) { __builtin_amdgcn_s_sleep(1); \
    if ((++_sp & 255u) == 0u) { if (xb_ld(&(bar)[XB_TMO])) break; if (_sp > XB_SPIN_CAP) { atomicAdd(&(bar)[XB_TMO], 1u); break; } } } } while (0)

struct XcdBarrier {
    unsigned* bar; unsigned x;
    volatile LAS unsigned* st;
};

__device__ __forceinline__ XcdBarrier xcd_barrier_post(unsigned* bar, volatile LAS unsigned* st) {
    XcdBarrier b; b.bar = bar; b.x = xb_xcc_id(); b.st = st;
    if (threadIdx.x == 0) (void)xb_add(&bar[XB_XCNT(b.x)], 1u);
    return b;
}
__device__ __forceinline__ void xcd_barrier_complete(unsigned* bar, unsigned x, unsigned& nloc, unsigned& nx) {
    const unsigned G = gridDim.x * gridDim.y * gridDim.z;
    unsigned sum, cnt, mine, sp = 0u;
    for (;;) {
        sum = 0u; cnt = 0u; mine = 0u;
#pragma unroll
        for (unsigned j = 0; j < 16; ++j) { const unsigned c = xb_ld(&bar[XB_XCNT(j)]); sum += c; cnt += (c > 0u) ? 1u : 0u; mine = (j == x) ? c : mine; }
        if (sum == G) break;
        __builtin_amdgcn_s_sleep(1);
        if ((++sp & 255u) == 0u) { if (xb_ld(&bar[XB_TMO])) break; if (sp > XB_SPIN_CAP) { atomicAdd(&bar[XB_TMO], 1u); break; } }
    }
    nloc = mine > 0u ? mine : 1u; nx = cnt > 0u ? cnt : 1u;
}

__device__ __forceinline__ void xcd_barrier(const XcdBarrier& b) {
    asm volatile("s_waitcnt vmcnt(0)" ::: "memory");
    __syncthreads();
    if (threadIdx.x == 0) {
        unsigned* bar = b.bar;
        __builtin_amdgcn_s_waitcnt(0);
        unsigned nloc = b.st[0], nx = b.st[1];
        if (nloc == 0u) { xcd_barrier_complete(bar, b.x, nloc, nx); b.st[0] = nloc; b.st[1] = nx; }
        const unsigned old = xb_add(&bar[XB_XSUB(b.x)], 1u);
        const unsigned gen = old / nloc;
        if (old + 1u == (gen + 1u) * nloc) {
            __builtin_amdgcn_fence(__ATOMIC_RELEASE, "agent");
            asm volatile("s_waitcnt vmcnt(0)" ::: "memory");
            const unsigned og = xb_add(&bar[XB_TOP], 1u);
            const unsigned tg = og / nx;
            if (og + 1u == (tg + 1u) * nx) xb_add(&bar[XB_TOPGEN], 1u);
            else XB_SPIN(xb_ld(&bar[XB_TOPGEN]) == tg, bar);
            __builtin_amdgcn_fence(__ATOMIC_ACQUIRE, "agent");
            xb_add(&bar[XB_XGEN(b.x)], 1u);
            asm volatile("s_waitcnt vmcnt(0)" ::: "memory");
        } else {
            XB_SPIN(xb_ld(&bar[XB_XGEN(b.x)]) == gen, bar);
            __builtin_amdgcn_fence(__ATOMIC_ACQUIRE, "agent");
            asm volatile("s_waitcnt vmcnt(0)" ::: "memory");
        }
    }
    __syncthreads();
}

struct Args { const float* in[17]; float* out; unsigned char* ws; int ph_lo, ph_hi; };

__device__ __forceinline__ void transpose_item(const float* W, int ldw, int K, bf16* WT, int item, int nblk, int split, LAS float* scr, int lane) {
    const int kb = item / nblk, nb = item % nblk, k0 = 64 * kb, n0 = 32 * nb;
    const int s0 = (split == 2) ? ((nb >> 2) & 1) * DFF + 128 * (nb >> 3) + 32 * (nb & 3)
                                : n0 + ((split == 1 && n0 >= C_GA) ? 16 : 0);
#pragma unroll 8
    for (int i = 0; i < 32; ++i) { const int kk = 2 * i + (lane >> 5); scr[kk * 33 + (lane & 31)] = W[(size_t)(k0 + kk) * ldw + s0 + (lane & 31)]; }
    asm volatile("s_waitcnt lgkmcnt(0)" ::: "memory");
    const int c = lane & 7;
#pragma unroll
    for (int j = 0; j < 4; ++j) { const int n = (lane >> 3) + 8 * j; const LAS float* s = scr + (8 * c) * 33 + n;
        v4u o; o.x = pk2(s[0 * 33], s[1 * 33]); o.y = pk2(s[2 * 33], s[3 * 33]); o.z = pk2(s[4 * 33], s[5 * 33]); o.w = pk2(s[6 * 33], s[7 * 33]);
        *(v4u*)(WT + (size_t)(n0 + n) * K + k0 + 8 * c) = o; }
    asm volatile("s_waitcnt lgkmcnt(0)" ::: "memory");
}

__device__ __forceinline__ void rms_row(const float* xrow, const float* gain, bf16* orow, int lane) {
    const f32x4* xr = (const f32x4*)xrow + lane;
    f32x4 v[8]; float s = 0.f;
#pragma unroll
    for (int j = 0; j < 8; ++j) { v[j] = xr[64 * j]; s += (v[j].x * v[j].x + v[j].y * v[j].y) + (v[j].z * v[j].z + v[j].w * v[j].w); }
    const float rinv = rsqrtf(wave_sum(s) * (1.f / DM) + EPS);
    const f32x4* gp = (const f32x4*)gain + lane;
    unsigned long long* o8 = (unsigned long long*)orow + lane;
#pragma unroll
    for (int j = 0; j < 8; ++j) { const f32x4 g = gp[64 * j];
        o8[64 * j] = (unsigned long long)pk2(v[j].x * rinv * g.x, v[j].y * rinv * g.y) | ((unsigned long long)pk2(v[j].z * rinv * g.z, v[j].w * rinv * g.w) << 32); }
}

__device__ __forceinline__ void rms_row_bf16(const bf16* xrow, const float* gain, bf16* orow, int lane) {
    const v4u* xr = (const v4u*)xrow + lane;
    v4u v[4]; float s = 0.f;
#pragma unroll
    for (int j = 0; j < 4; ++j) { v[j] = xr[64 * j];
#pragma unroll
        for (int e = 0; e < 4; ++e) { const float a = bflo(v[j][e]), b = bfhi(v[j][e]); s += a * a + b * b; } }
    const float rinv = rsqrtf(wave_sum(s) * (1.f / DM) + EPS);
    v4u* o = (v4u*)orow + lane;
#pragma unroll
    for (int j = 0; j < 4; ++j) { const f32x4 g0 = *(const f32x4*)(gain + 8 * (lane + 64 * j)), g1 = *(const f32x4*)(gain + 8 * (lane + 64 * j) + 4);
        v4u w; w.x = pk2(bflo(v[j].x) * rinv * g0.x, bfhi(v[j].x) * rinv * g0.y); w.y = pk2(bflo(v[j].y) * rinv * g0.z, bfhi(v[j].y) * rinv * g0.w);
        w.z = pk2(bflo(v[j].z) * rinv * g1.x, bfhi(v[j].z) * rinv * g1.y); w.w = pk2(bflo(v[j].w) * rinv * g1.z, bfhi(v[j].w) * rinv * g1.w);
        o[64 * j] = w; }
}

__global__ void __launch_bounds__(512, 2) mega(Args a) {
    extern __shared__ __attribute__((aligned(16))) unsigned char lds_raw[];
    cg::grid_group grid = cg::this_grid();
    LAS unsigned char* lds = (LAS unsigned char*)lds_raw;
    const int G = gridDim.x, NGW = G * 8;
    unsigned char* ws = a.ws;
    bf16* WB = (bf16*)(ws + WS_W);
    bf16* P = (bf16*)(ws + WS_P);
    bf16* H = (bf16*)(ws + WS_R + R_H);
    bf16* YA = (bf16*)(ws + WS_R + R_YA);
    bf16* YB = (bf16*)(ws + WS_R + R_YB);
    bf16* MG = (bf16*)(ws + WS_R + R_MG);
    bf16* XM = (bf16*)(ws + WS_R + R_YA);
    bf16* ACT = (bf16*)(ws + WS_P);
    bf16* PRAW = (bf16*)(ws + WS_P + 180 * MiB);
    bf16* DQ = (bf16*)(ws + WS_R + R_DQ);
    bf16* DK = (bf16*)(ws + WS_R + R_DK);
    bf16* DV = (bf16*)(ws + WS_R + R_DV);
    bf16* TB = (bf16*)(ws + WS_R + R_TB);
    bf16* AB = (bf16*)(ws + WS_R + R_AB);
    float* BETA = (float*)(ws + WS_BG);
    float* GG = BETA + (size_t)TT * 8;
    float* KM = (float*)(ws + WS_KM);
    volatile LAS unsigned* bst = (volatile LAS unsigned*)(lds + LDS_BYTES - 16);
    if (threadIdx.x < 4) bst[threadIdx.x] = 0u;
    __syncthreads();
    const XcdBarrier xbar = xcd_barrier_post((unsigned*)(ws + 65536), bst);
    unsigned* ctr = (unsigned*)ws;
    if (blockIdx.x == 0 && threadIdx.x == 0 && a.ph_lo == 0) { ctr[0] = 0u; ctr[1] = 0u; ctr[2] = 0u; ctr[3] = 0u; }

#ifndef PROBE_MASK
#define PROBE_MASK 0
#endif
    for (int it = 2 * a.ph_lo; it < 2 * a.ph_hi; ++it) {
        const int ph = it >> 1, rep = it & 1;
        const int l = ph / NPH, p = ph % NPH;
        if (rep == 1 && !((PROBE_MASK >> p) & 1)) continue;
        if (p == 4) continue;
        int tid = threadIdx.x; asm volatile("" : "+v"(tid));
        const int lane = tid & 63, wave = __builtin_amdgcn_readfirstlane(tid >> 6), gw = blockIdx.x * 8 + wave;
        const float* xin = (l == 0) ? a.in[0] : a.out;

        if (p == 0) {
            LAS float* scr = (LAS float*)(lds + wave * 16384);
            const float* w_in = a.in[2] + (size_t)l * DM * INC;
            const float* w_a = a.in[9] + (size_t)l * 1024 * DM;
            const float* w_b = a.in[10] + (size_t)l * 1024 * DM;
            const float* w_o = a.in[11] + (size_t)l * DM * DM;
            const float* w_fi = a.in[13] + (size_t)l * DM * NP;
            const float* w_fd = a.in[16] + (size_t)l * DFF * DM;
            constexpr int I_IN = 32 * 352, I_BA = 32;
            for (int it = gw; it < I_IN + I_BA; it += NGW) {
                if (it < I_IN) transpose_item(w_in, INC, DM, WB + W_IN, it, 352, 1, scr, lane);
                else transpose_item(w_in + C_GA, INC, DM, WB + W_BA, it - I_IN, 1, 0, scr, lane);
            }
            const float* gain = a.in[1] + (size_t)l * DM;
            for (int row = gw; row < TT; row += NGW) rms_row(xin + (size_t)row * DM, gain, H + (size_t)row * DM, lane);
        }
        else if (p == 1 || p == 8) {
            pg8::Gemm g{H, WB + (p == 1 ? W_IN : W_FI), TT, NP, DM}; pg8::StaticOrder S; S.init(TT, NP, G, (int)blockIdx.x);
            if (p == 1) { pg8::EpiProj E{P, NP, a.in[3] + l * 128, a.in[4] + l * 128, KM, (LAS float*)(lds + 131072), QSCALE_L2E, EPS}; pg8::gemm_phase<pg8::EpiProj, pg8::StaticOrder, true, true>(lds, g, S, E); }
            else { pg8::EpiGLU E{ACT, PRAW, a.in[14] + (size_t)l * 3 * DFF, a.in[15] + (size_t)l * DFF, (LAS float*)(lds + 131072)};
                   pg8::gemm_phase<pg8::EpiGLU, pg8::StaticOrder, true, true>(lds, g, S, E); }
            if (p == 1) {
            __syncthreads();
            for (int tp = blockIdx.x; tp < TT / 64; tp += G) {
                const int r = lane & 31, hh = lane >> 5, tile = 2 * tp + (wave >> 2), kq = wave & 3;
                const float* alog = a.in[6] + l * 8; const float* dtb = a.in[7] + l * 8;
                const bf16* ap = H + (size_t)(tile * 32 + r) * DM + 512 * kq + 8 * hh;
                const bf16* bp = WB + W_BA + (size_t)r * DM + 512 * kq + 8 * hh;
                f32x16 acc;
#pragma unroll
                for (int i = 0; i < 16; ++i) acc[i] = 0.f;
#pragma unroll 16
                for (int k0 = 0; k0 < 512; k0 += 16) {
                    const bf16x8 av = *(const bf16x8*)(ap + k0); const bf16x8 bv = *(const bf16x8*)(bp + k0);
                    acc = __builtin_amdgcn_mfma_f32_32x32x16_bf16(av, bv, acc, 0, 0, 0);
                }
                LAS float* part = (LAS float*)lds + (wave * 64 + lane) * 16;
#pragma unroll
                for (int i = 0; i < 4; ++i) *(LAS f32x4*)(part + 4 * i) = (f32x4){acc[4 * i], acc[4 * i + 1], acc[4 * i + 2], acc[4 * i + 3]};
                __syncthreads();
                if (kq == 0 && r < 16) {
#pragma unroll
                    for (int q = 1; q < 4; ++q)
#pragma unroll
                        for (int i = 0; i < 4; ++i) { const f32x4 t = *(const LAS f32x4*)(part + q * 1024 + 4 * i); acc[4 * i] += t[0]; acc[4 * i + 1] += t[1]; acc[4 * i + 2] += t[2]; acc[4 * i + 3] += t[3]; }
                    const int hd = r & 7; const float A = __expf(alog[hd]), db = dtb[hd];
#pragma unroll
                    for (int i = 0; i < 16; ++i) { const int row = tile * 32 + crow(i, hh); const float v = acc[i];
                        if (r < 8) BETA[(size_t)row * 8 + hd] = 1.f / (1.f + __expf(-v));
                        else { const float z = v + db; const float sp = (z > 20.f) ? z : log1pf(__expf(z)); GG[(size_t)row * 8 + hd] = -A * sp; } }
                }
                __syncthreads();
            }
            }
        }
        else if (p == 2) {
            {
                const float* cw = a.in[5] + (size_t)l * 4 * 3072;
                dn_prep_phase(lds, P, cw, DQ, DK, DV, BETA, GG, TB, AB, G, tid, wave);
            }
        }
        else if (p == 3) {
            for (int item = blockIdx.x; item < 32; item += G) dn_seq(lds, P, DQ, DK, DV, BETA, GG, TB, AB, YB, a.in[8] + l * 128, item >> 3, item & 7, tid, lane, wave);
            __syncthreads();
            {
                LAS int* itemp = (LAS int*)(lds + LDS_BYTES - 32);
                constexpr int I_A = 16 * 64, I_O = 32 * 64, I_FI = 32 * 352, I_FD = 88 * 64, NFILL = (2 * I_A + I_O + I_FI + I_FD) / 32;
                for (;;) {
                    if (tid == 0) *itemp = (int)__hip_atomic_fetch_add(ctr + 2 * l + rep, 1u, __ATOMIC_RELAXED, __HIP_MEMORY_SCOPE_AGENT);
                    __syncthreads();
                    const int it = *itemp;
                    __syncthreads();
                    if (it >= 512 + NFILL) break;
                    if (it < 512) { const int qb = 15 - (it >> 5), bh = it & 31; moba_item(lds, P, KM, YA, bh >> 3, bh & 7, qb, tid, lane, wave); }
                    else {
                        LAS float* scr = (LAS float*)(lds + wave * 16384);
#pragma unroll 1
                        for (int j = 0; j < 4; ++j) { int r = (it - 512) * 32 + j * 8 + wave;
                            const float* W; int ldw, K, nblk, split; size_t doff;
                            if (r < I_A) { W = a.in[9] + (size_t)l * 1024 * DM; ldw = DM; K = 1024; nblk = 64; split = 0; doff = W_A; }
                            else if ((r -= I_A) < I_A) { W = a.in[10] + (size_t)l * 1024 * DM; ldw = DM; K = 1024; nblk = 64; split = 0; doff = W_B; }
                            else if ((r -= I_A) < I_O) { W = a.in[11] + (size_t)l * DM * DM; ldw = DM; K = DM; nblk = 64; split = 0; doff = W_O; }
                            else if ((r -= I_O) < I_FI) { W = a.in[13] + (size_t)l * DM * NP; ldw = NP; K = DM; nblk = 352; split = 2; doff = W_FI; }
                            else { r -= I_FI; W = a.in[16] + (size_t)l * DFF * DM; ldw = DM; K = DFF; nblk = 64; split = 0; doff = W_FD; }
                            transpose_item(W, ldw, K, WB + doff, r, nblk, split, scr, lane); }
                    }
                }
            }
        }
        else if (p == 4) {
            const float* og = a.in[8] + l * 128;
            const float og0 = og[2 * lane], og1 = og[2 * lane + 1];
            for (int idx = gw; idx < TT * 8; idx += NGW) {
                const int row = idx >> 3, h = idx & 7;
                const unsigned uo = *(const unsigned*)(P + (size_t)row * NP + C_DQ + h * 128 + 2 * lane);
                const unsigned uz = *(const unsigned*)(P + (size_t)row * NP + C_DZ + h * 128 + 2 * lane);
                const float o0 = bflo(uo), o1 = bfhi(uo);
                const float r = rsqrtf(wave_sum(o0 * o0 + o1 * o1) * (1.f / 128) + EPS);
                *(unsigned*)(YB + (size_t)row * 1024 + h * 128 + 2 * lane) = pk2(o0 * r * og0 * siluf_(bflo(uz)), o1 * r * og1 * siluf_(bfhi(uz)));
            }
        }
        else if (p == 5) {
            for (int pass = 0; pass < 2; ++pass) {
                pg8::Gemm g{pass ? YB : YA, WB + (pass ? W_B : W_A), TT, DM, 1024}; pg8::StaticOrder S; S.init(TT, DM, G, (int)blockIdx.x);
                pg8::EpiGate E{MG, DM, P + (pass ? C_GB : C_GA), NP, pass};
                pg8::gemm_phase<pg8::EpiGate, pg8::StaticOrder, true, true>(lds, g, S, E);
            }
        }
        else if (p == 6 || p == 10) {
            pg8::Gemm g{p == 6 ? MG : ACT, WB + (p == 6 ? W_O : W_FD), TT, DM, p == 6 ? DM : DFF}; pg8::StaticOrder S; S.init(TT, DM, G, (int)blockIdx.x);
            pg8::EpiResid E{xin, p == 6 ? (const bf16*)nullptr : (const bf16*)XM, a.out, p == 6 ? XM : (bf16*)nullptr, DM};
            pg8::gemm_phase<pg8::EpiResid, pg8::StaticOrder, true, true>(lds, g, S, E);
        }
        else if (p == 7) {
            const float* gain = a.in[12] + (size_t)l * DM;
            for (int row = gw; row < TT; row += NGW) rms_row_bf16(XM + (size_t)row * DM, gain, H + (size_t)row * DM, lane);
        }
        else if (p == 9) {
            const float* cw = a.in[14] + (size_t)l * 3 * DFF; const float* cb = a.in[15] + (size_t)l * DFF;
            for (int idx = blockIdx.x * 512 + tid; idx < 64 * (DFF / 8); idx += G * 512) {
                const int pm = idx / (DFF / 8), col = (idx % (DFF / 8)) * 8, t0 = pm * 256;
                if ((t0 & (SEQ - 1)) == 0) continue;
                float x[4][8], up[2][8];
#pragma unroll
                for (int i = 0; i < 4; ++i) { const v4u pg = *(const v4u*)(PRAW + (size_t)(i < 2 ? (pm - 1) * 4 + 2 + i : pm * 4 + i - 2) * NP + col);
#pragma unroll
                    for (int e = 0; e < 4; ++e) { x[i][2 * e] = bflo(pg[e]); x[i][2 * e + 1] = bfhi(pg[e]); } }
#pragma unroll
                for (int i = 0; i < 2; ++i) { const v4u pu = *(const v4u*)(PRAW + (size_t)(pm * 4 + i) * NP + DFF + col);
#pragma unroll
                    for (int e = 0; e < 4; ++e) { up[i][2 * e] = bflo(pu[e]); up[i][2 * e + 1] = bfhi(pu[e]); } }
#pragma unroll
                for (int i = 0; i < 2; ++i) { float r[8];
#pragma unroll
                    for (int e = 0; e < 8; ++e) { const float gt = cw[col + e] * x[i][e] + cw[DFF + col + e] * x[i + 1][e] + cw[2 * DFF + col + e] * x[i + 2][e] + cb[col + e]; r[e] = siluf_(gt) * up[i][e]; }
                    v4u w; w.x = pk2(r[0], r[1]); w.y = pk2(r[2], r[3]); w.z = pk2(r[4], r[5]); w.w = pk2(r[6], r[7]);
                    *(v4u*)(ACT + (size_t)(t0 + i) * DFF + col) = w; }
            }
        }
        if (it + 2 < 2 * a.ph_hi) xcd_barrier(xbar);
    }
    if (a.ph_lo > a.ph_hi) grid.sync();
}

extern "C" void kernel_launch(void* const* d_in, const int* in_sizes, int n_in, void* d_out, int out_size, void* d_ws, size_t ws_size, hipStream_t stream) {
    static int grid = 0;
    if (grid == 0) {
        if (n_in != 17 || out_size != TT * DM || ws_size < WS_END) { fprintf(stderr, "kernel_launch: unexpected shapes / workspace (%d inputs, out %d, ws %zu)\n", n_in, out_size, ws_size); grid = -1; return; }
        int dev = 0, cus = 0, per_cu = 0;
        if (hipGetDevice(&dev) != hipSuccess || hipDeviceGetAttribute(&cus, hipDeviceAttributeMultiprocessorCount, dev) != hipSuccess) { grid = -1; return; }
        if (hipFuncSetAttribute((const void*)mega, hipFuncAttributeMaxDynamicSharedMemorySize, LDS_BYTES) != hipSuccess) { grid = -1; return; }
        if (hipOccupancyMaxActiveBlocksPerMultiprocessor(&per_cu, (const void*)mega, 512, LDS_BYTES) != hipSuccess || per_cu < 1) { fprintf(stderr, "kernel_launch: occupancy query says %d\n", per_cu); per_cu = 1; }
        (void)hipGetLastError();
        grid = cus * per_cu;
    }
    if (grid < 0) return;
    Args a{};
    for (int i = 0; i < 17; ++i) a.in[i] = (const float*)d_in[i];
    a.out = (float*)d_out; a.ws = (unsigned char*)d_ws; a.ph_lo = 0; a.ph_hi = 2 * NPH;
    if (hipMemsetAsync(d_ws, 0, 128 * 1024, stream) != hipSuccess) { fprintf(stderr, "kernel_launch: memset of the control words failed\n"); return; }
    void* args[] = {&a};
    hipError_t e = hipLaunchCooperativeKernel((const void*)mega, dim3(grid), dim3(512), args, LDS_BYTES, stream);
    if (e != hipSuccess) fprintf(stderr, "cooperative launch failed: %s (grid %d)\n", hipGetErrorString(e), grid);
}
```

```cpp
#include <hip/hip_runtime.h>
#include <hip/hip_cooperative_groups.h>
#include <cstdio>
#include <cstdint>
namespace cg = cooperative_groups;
namespace pg8 {
#define PG8_LAS __attribute__((address_space(3)))
typedef unsigned short bf16_t;
typedef short bf16x8 __attribute__((ext_vector_type(8)));
typedef float f32x4 __attribute__((ext_vector_type(4)));
typedef unsigned u32x4 __attribute__((ext_vector_type(4)));
constexpr int BM = 256, BK = 64, HALF = 128, HTB = HALF * BK * 2  , STAGE_BYTES = 8 * HTB, NXCD = 8, WGM = 4;

__host__ __device__ __forceinline__ int lds_byte(int r, int c) { const int st = (r >> 4) * 2 + (c >> 5), rr = r & 15, cc = c & 31, ob = rr * 64 + cc * 2; return st * 1024 + (ob ^ (((ob >> 9) & 1) << 5)); }
__host__ __device__ __forceinline__ void stage_rc(int b, int& R, int& C) { const int st = b / 1024, sb = b % 1024, swz = sb ^ (((sb >> 9) & 1) << 5); R = (st >> 1) * 16 + swz / 64; C = (st & 1) * 32 + (swz % 64) / 2; }
__host__ __device__ __forceinline__ int perm32(int rho) { const int n = rho >> 4, i = rho & 15; return 8 * (i >> 2) + 4 * n + (i & 3); }

struct Unit { int pm, pn; };
struct Gemm { const bf16_t* A; const bf16_t* Bt; int M, N, K; };

struct StaticOrder {
    int nM, nN, nwg, G, c;
    __host__ __device__ void init(int M, int N, int G_, int c_) { nM = M / BM; nN = N / BM; nwg = nM * nN; G = G_; c = c_; }
    __host__ __device__ bool next(int i, Unit& u) const {
        const long L = (long)i * G + c; if (L >= nwg) return false;
        int wgid = (int)L; { const int q = nwg / NXCD, r = nwg % NXCD, xcd = wgid % NXCD, off = wgid / NXCD; wgid = (xcd < r ? xcd * (q + 1) : r * (q + 1) + (xcd - r) * q) + off; }
        const int nig = WGM * nN, gid = wgid / nig, fm = gid * WGM, gsz = (nM - fm) < WGM ? (nM - fm) : WGM;
        u.pm = fm + ((wgid % nig) % gsz); u.pn = (wgid % nig) / gsz; return true;
    }
    __device__ __forceinline__ void a_ready(const Unit&) const {}
    __device__ __forceinline__ void done(const Unit&) const {}
};

__device__ __forceinline__ unsigned cvt_pk_bf16(float lo, float hi) { unsigned r; asm volatile("v_cvt_pk_bf16_f32 %0, %1, %2" : "=v"(r) : "v"(lo), "v"(hi)); return r; }
__device__ __forceinline__ float sigm(float x) { return __builtin_amdgcn_rcpf(1.f + __expf(-x)); }
struct EpiBf16S {
    static constexpr bool PERM = true, AFTER_DRAIN = false;
    bf16_t* O; int ldc;
    __device__ __forceinline__ void operator()(const f32x4 (&acc)[2][2][4][2], const Unit& u, int wr, int wc, int fr, int fq) const {
        const int row0 = u.pm * BM + wr * 64 + fr, col0 = u.pn * BM + wc * 32 + 8 * fq;
#pragma unroll
        for (int ai = 0; ai < 2; ++ai)
#pragma unroll
            for (int m = 0; m < 4; ++m) { bf16_t* rowp = O + (size_t)(row0 + ai * HALF + m * 16) * ldc + col0;
#pragma unroll
                for (int bj = 0; bj < 2; ++bj) { const f32x4 v0 = acc[ai][bj][m][0], v1 = acc[ai][bj][m][1];
                    u32x4 w; w.x = cvt_pk_bf16(v0[0], v0[1]); w.y = cvt_pk_bf16(v0[2], v0[3]); w.z = cvt_pk_bf16(v1[0], v1[1]); w.w = cvt_pk_bf16(v1[2], v1[3]);
                    *(u32x4*)(rowp + bj * HALF) = w; } }
    }
};
struct EpiResid {
    static constexpr bool PERM = true, AFTER_DRAIN = false;
    const float* R; const bf16_t* Rb; float* O; bf16_t* Ob; int ld;
    __device__ __forceinline__ void operator()(const f32x4 (&acc)[2][2][4][2], const Unit& u, int wr, int wc, int fr, int fq) const {
        const int row0 = u.pm * BM + wr * 64 + fr, col0 = u.pn * BM + wc * 32 + 8 * fq;
#pragma unroll
        for (int ai = 0; ai < 2; ++ai)
#pragma unroll
            for (int m = 0; m < 4; ++m) { const size_t ro = (size_t)(row0 + ai * HALF + m * 16) * ld + col0;
#pragma unroll
                for (int bj = 0; bj < 2; ++bj) { const size_t off = ro + bj * HALF;
                    f32x4 r0, r1;
                    if (Rb) { const u32x4 rb = *(const u32x4*)(Rb + off);
                        r0 = (f32x4){__uint_as_float(rb.x << 16), __uint_as_float(rb.x & 0xffff0000u), __uint_as_float(rb.y << 16), __uint_as_float(rb.y & 0xffff0000u)};
                        r1 = (f32x4){__uint_as_float(rb.z << 16), __uint_as_float(rb.z & 0xffff0000u), __uint_as_float(rb.w << 16), __uint_as_float(rb.w & 0xffff0000u)}; }
                    else { r0 = *(const f32x4*)(R + off); r1 = *(const f32x4*)(R + off + 4); }
                    const f32x4 v0 = r0 + acc[ai][bj][m][0], v1 = r1 + acc[ai][bj][m][1];
                    if (Ob) { u32x4 w; w.x = cvt_pk_bf16(v0[0], v0[1]); w.y = cvt_pk_bf16(v0[2], v0[3]); w.z = cvt_pk_bf16(v1[0], v1[1]); w.w = cvt_pk_bf16(v1[2], v1[3]); *(u32x4*)(Ob + off) = w; }
                    else { *(f32x4*)(O + off) = v0; *(f32x4*)(O + off + 4) = v1; } } }
    }
};
template <int CTRL> __device__ __forceinline__ float dpp_mov(float v) { return __builtin_bit_cast(float, __builtin_amdgcn_update_dpp(0, __builtin_bit_cast(int, v), CTRL, 0xf, 0xf, false)); }
struct EpiGLU {
    static constexpr bool PERM = true, AFTER_DRAIN = false;
    bf16_t* ACT; bf16_t* Praw; const float* cw; const float* cb; PG8_LAS float* xch;
    __device__ __forceinline__ void operator()(const f32x4 (&acc)[2][2][4][2], const Unit& u, int wr, int wc, int fr, int fq) const {
        const int colg = wc * 32 + 8 * fq, j0 = u.pn * 128 + colg;
        if (fr >= 14) {
#pragma unroll
            for (int ai = 0; ai < 2; ++ai)
#pragma unroll
                for (int n = 0; n < 2; ++n) *(PG8_LAS f32x4*)(xch + (((ai * 2 + wr) * 2 + (fr - 14)) * 128 + colg + 4 * n)) = acc[ai][0][3][n];
        }
        asm volatile("s_waitcnt lgkmcnt(0)" ::: "memory"); __builtin_amdgcn_s_barrier(); asm volatile("" ::: "memory");
        f32x4 w0[2], w1[2], w2[2], bs[2];
#pragma unroll
        for (int n = 0; n < 2; ++n) { w0[n] = *(const f32x4*)(cw + j0 + 4 * n); w1[n] = *(const f32x4*)(cw + 5632 + j0 + 4 * n); w2[n] = *(const f32x4*)(cw + 2 * 5632 + j0 + 4 * n); bs[n] = *(const f32x4*)(cb + j0 + 4 * n); }
#pragma unroll
        for (int ai = 0; ai < 2; ++ai) {
            const int chunk = ai * 2 + wr;
            f32x4 a1[2], a2[2];
#pragma unroll
            for (int n = 0; n < 2; ++n) { a1[n] = (f32x4){0.f, 0.f, 0.f, 0.f}; a2[n] = a1[n]; }
            if (chunk > 0) {
#pragma unroll
                for (int n = 0; n < 2; ++n) { a1[n] = *(const PG8_LAS f32x4*)(xch + (((chunk - 1) * 2 + 1) * 128 + colg + 4 * n)); a2[n] = *(const PG8_LAS f32x4*)(xch + (((chunk - 1) * 2 + 0) * 128 + colg + 4 * n)); }
            }
#pragma unroll
            for (int m = 0; m < 4; ++m) {
                const int row = u.pm * BM + ai * HALF + wr * 64 + m * 16 + fr;
                float o[8];
#pragma unroll
                for (int n = 0; n < 2; ++n)
#pragma unroll
                    for (int e = 0; e < 4; ++e) {
                        const float g0 = acc[ai][0][m][n][e];
                        const float r1 = dpp_mov<0x121>(g0), r2 = dpp_mov<0x122>(g0);
                        float p1, p2;
                        if (m > 0) { const float gp = acc[ai][0][m > 0 ? m - 1 : 0][n][e]; p1 = dpp_mov<0x121>(gp); p2 = dpp_mov<0x122>(gp); }
                        else { p1 = a1[n][e]; p2 = (fr == 1) ? a1[n][e] : a2[n][e]; }
                        const float g1 = (fr >= 1) ? r1 : p1, g2 = (fr >= 2) ? r2 : p2;
                        const float cv = w0[n][e] * g2 + w1[n][e] * g1 + w2[n][e] * g0 + bs[n][e];
                        o[4 * n + e] = cv * __builtin_amdgcn_rcpf(1.f + __expf(-cv)) * acc[ai][1][m][n][e];
                    }
                u32x4 w; w.x = cvt_pk_bf16(o[0], o[1]); w.y = cvt_pk_bf16(o[2], o[3]); w.z = cvt_pk_bf16(o[4], o[5]); w.w = cvt_pk_bf16(o[6], o[7]);
                *(u32x4*)(ACT + (size_t)row * 5632 + j0) = w;
                if ((chunk == 0 && m == 0 && fr < 2) || (chunk == 3 && m == 3 && fr >= 14)) {
                    const f32x4 gA = acc[ai][0][m][0], gB = acc[ai][0][m][1], uA = acc[ai][1][m][0], uB = acc[ai][1][m][1];
                    u32x4 wg, wu; wg.x = cvt_pk_bf16(gA[0], gA[1]); wg.y = cvt_pk_bf16(gA[2], gA[3]); wg.z = cvt_pk_bf16(gB[0], gB[1]); wg.w = cvt_pk_bf16(gB[2], gB[3]);
                    wu.x = cvt_pk_bf16(uA[0], uA[1]); wu.y = cvt_pk_bf16(uA[2], uA[3]); wu.z = cvt_pk_bf16(uB[0], uB[1]); wu.w = cvt_pk_bf16(uB[2], uB[3]);
                    const size_t ro = (size_t)(u.pm * 4 + (chunk == 0 ? fr : fr - 12)) * 11264;
                    *(u32x4*)(Praw + ro + j0) = wg; *(u32x4*)(Praw + ro + 5632 + j0) = wu;
                }
            }
        }
    }
};
struct EpiProj {
    static constexpr bool PERM = true, AFTER_DRAIN = false;
    bf16_t* O; int ldc; const float* qgain; const float* kgain; float* KM; PG8_LAS float* xs; float qpost, eps;
    __device__ __forceinline__ void operator()(const f32x4 (&acc)[2][2][4][2], const Unit& u, int wr, int wc, int fr, int fq) const {
        const int row0 = u.pm * BM + wr * 64 + fr, col0 = u.pn * BM + wc * 32 + 8 * fq;
        if (u.pn >= 8) {
#pragma unroll
            for (int ai = 0; ai < 2; ++ai)
#pragma unroll
                for (int m = 0; m < 4; ++m) { bf16_t* rowp = O + (size_t)(row0 + ai * HALF + m * 16) * ldc + col0;
#pragma unroll
                    for (int bj = 0; bj < 2; ++bj) { const f32x4 v0 = acc[ai][bj][m][0], v1 = acc[ai][bj][m][1];
                        u32x4 w; w.x = cvt_pk_bf16(v0[0], v0[1]); w.y = cvt_pk_bf16(v0[2], v0[3]); w.z = cvt_pk_bf16(v1[0], v1[1]); w.w = cvt_pk_bf16(v1[2], v1[3]);
                        *(u32x4*)(rowp + bj * HALF) = w; } }
            return;
        }
        const bool isk = u.pn >= 4;
#pragma unroll
        for (int ai = 0; ai < 2; ++ai)
#pragma unroll
            for (int m = 0; m < 4; ++m)
#pragma unroll
                for (int bj = 0; bj < 2; ++bj) { const f32x4 a0 = acc[ai][bj][m][0], a1 = acc[ai][bj][m][1];
                    float sq = (a0[0] * a0[0] + a0[1] * a0[1]) + (a0[2] * a0[2] + a0[3] * a0[3]) + (a1[0] * a1[0] + a1[1] * a1[1]) + (a1[2] * a1[2] + a1[3] * a1[3]);
                    sq += __shfl_xor(sq, 16); sq += __shfl_xor(sq, 32);
                    if (fq == 0) xs[((((ai * 2 + wr) * 2 + bj) * 4 + m) * 16 + fr) * 4 + wc] = sq; }
        asm volatile("s_waitcnt lgkmcnt(0)" ::: "memory"); __builtin_amdgcn_s_barrier(); asm volatile("" ::: "memory");
        const float* gain = (isk ? kgain : qgain) + wc * 32 + 8 * fq;
        const f32x4 g0 = *(const f32x4*)gain, g1 = *(const f32x4*)(gain + 4);
        const float post = isk ? 1.f : qpost;
        PG8_LAS float* ks = xs + 2048;
#pragma unroll
        for (int bj = 0; bj < 2; ++bj) {
            int rq = row0; asm volatile("" : "+v"(rq));
            f32x4 c0 = (f32x4){0.f, 0.f, 0.f, 0.f}, c1 = c0;
#pragma unroll
            for (int ai = 0; ai < 2; ++ai)
#pragma unroll
                for (int m = 0; m < 4; ++m) { bf16_t* rowp = O + (size_t)(rq + ai * HALF + m * 16) * ldc + col0 + bj * HALF;
                    const f32x4 t = *(const PG8_LAS f32x4*)(xs + ((((ai * 2 + wr) * 2 + bj) * 4 + m) * 16 + fr) * 4);
                    const float rinv = rsqrtf(((t[0] + t[1]) + (t[2] + t[3])) * (1.f / 128) + eps) * post;
                    const f32x4 v0 = acc[ai][bj][m][0] * rinv * g0, v1 = acc[ai][bj][m][1] * rinv * g1;
                    c0 += v0; c1 += v1;
                    u32x4 w; w.x = cvt_pk_bf16(v0[0], v0[1]); w.y = cvt_pk_bf16(v0[2], v0[3]); w.z = cvt_pk_bf16(v1[0], v1[1]); w.w = cvt_pk_bf16(v1[2], v1[3]);
                    *(u32x4*)rowp = w; }
            if (isk) {
#pragma unroll
                for (int e = 0; e < 4; ++e) { float v = c0[e]; v += dpp_mov<0xB1>(v); v += dpp_mov<0x4E>(v); v += dpp_mov<0x141>(v); v += dpp_mov<0x140>(v); c0[e] = v;
                    float x = c1[e]; x += dpp_mov<0xB1>(x); x += dpp_mov<0x4E>(x); x += dpp_mov<0x141>(x); x += dpp_mov<0x140>(x); c1[e] = x; }
                if (fr == 0) { *(PG8_LAS f32x4*)(ks + (((wr * 2 + bj) * 4 + wc) * 4 + fq) * 8) = c0; *(PG8_LAS f32x4*)(ks + (((wr * 2 + bj) * 4 + wc) * 4 + fq) * 8 + 4) = c1; }
            }
        }
        if (isk) {
            asm volatile("s_waitcnt lgkmcnt(0)" ::: "memory"); __builtin_amdgcn_s_barrier(); asm volatile("" ::: "memory");
            if (wr == 0 && fr == 0) {
                const int b = u.pm >> 4, nb = u.pm & 15;
#pragma unroll
                for (int bj = 0; bj < 2; ++bj) { const int h = 2 * (u.pn - 4) + bj;
                    float* kmp = KM + ((size_t)(b * 8 + h) * 16 + nb) * 128 + wc * 32 + 8 * fq;
#pragma unroll
                    for (int n = 0; n < 2; ++n) { const f32x4 x0 = *(const PG8_LAS f32x4*)(ks + (((0 * 2 + bj) * 4 + wc) * 4 + fq) * 8 + n * 4), x1 = *(const PG8_LAS f32x4*)(ks + (((1 * 2 + bj) * 4 + wc) * 4 + fq) * 8 + n * 4);
                        *(f32x4*)(kmp + 4 * n) = (x0 + x1) * (1.f / 256); } }
            }
        }
    }
};
struct EpiGate {
    static constexpr bool PERM = true, AFTER_DRAIN = false;
    bf16_t* O; int ldo; const bf16_t* Gt; int ldg; int accum;
    __device__ __forceinline__ void operator()(const f32x4 (&acc)[2][2][4][2], const Unit& u, int wr, int wc, int fr, int fq) const {
        const int row0 = u.pm * BM + wr * 64 + fr, col0 = u.pn * BM + wc * 32 + 8 * fq;
#pragma unroll
        for (int ai = 0; ai < 2; ++ai)
#pragma unroll
            for (int m = 0; m < 4; ++m) { const size_t r = (size_t)(row0 + ai * HALF + m * 16);
#pragma unroll
                for (int bj = 0; bj < 2; ++bj) { const int c = col0 + bj * HALF;
                    const u32x4 gt = *(const u32x4*)(Gt + r * ldg + c);
                    const f32x4 a0 = acc[ai][bj][m][0], a1 = acc[ai][bj][m][1];
                    float v[8];
                    v[0] = a0[0] * sigm(__uint_as_float(gt.x << 16)); v[1] = a0[1] * sigm(__uint_as_float(gt.x & 0xffff0000u));
                    v[2] = a0[2] * sigm(__uint_as_float(gt.y << 16)); v[3] = a0[3] * sigm(__uint_as_float(gt.y & 0xffff0000u));
                    v[4] = a1[0] * sigm(__uint_as_float(gt.z << 16)); v[5] = a1[1] * sigm(__uint_as_float(gt.z & 0xffff0000u));
                    v[6] = a1[2] * sigm(__uint_as_float(gt.w << 16)); v[7] = a1[3] * sigm(__uint_as_float(gt.w & 0xffff0000u));
                    bf16_t* op = O + r * ldo + c;
                    if (accum) { const u32x4 pv = *(const u32x4*)op;
                        v[0] += __uint_as_float(pv.x << 16); v[1] += __uint_as_float(pv.x & 0xffff0000u);
                        v[2] += __uint_as_float(pv.y << 16); v[3] += __uint_as_float(pv.y & 0xffff0000u);
                        v[4] += __uint_as_float(pv.z << 16); v[5] += __uint_as_float(pv.z & 0xffff0000u);
                        v[6] += __uint_as_float(pv.w << 16); v[7] += __uint_as_float(pv.w & 0xffff0000u); }
                    u32x4 w; w.x = cvt_pk_bf16(v[0], v[1]); w.y = cvt_pk_bf16(v[2], v[3]); w.z = cvt_pk_bf16(v[4], v[5]); w.w = cvt_pk_bf16(v[6], v[7]);
                    *(u32x4*)op = w; } }
    }
};
template <class Epi, class Sched, bool ALIGN_EPI = false, bool SP2 = false>
__device__ __forceinline__ void gemm_phase(PG8_LAS unsigned char* lds, const Gemm g, const Sched& S, const Epi& E) {
    int tid = threadIdx.x; asm volatile("" : "+v"(tid));
    const int wid = __builtin_amdgcn_readfirstlane(tid >> 6), lane = tid & 63, wr = wid >> 2, wc = wid & 3, fr = lane & 15, fq = lane >> 4;
    const int K = g.K, nt = K / BK;
    unsigned voffA[2], voffB[2];
#pragma unroll
    for (int i = 0; i < 2; ++i) { int R, C; stage_rc(tid * 16 + i * 8192, R, C); const int Rb = Epi::PERM ? ((R & ~31) + perm32(R & 31)) : R;
        voffA[i] = (unsigned)(R * K + C) * 2u; voffB[i] = (unsigned)(Rb * K + C) * 2u; }
    const size_t kstep = (size_t)(BK * 2);
    const size_t hstep = (size_t)HALF * K * 2;
    const size_t tstep = 2 * hstep;
    const unsigned ldsw = (unsigned)wid * 1024u;
    const int aoff = lds_byte(wr * 64 + fr, fq * 8), boff = lds_byte(wc * 32 + fr, fq * 8);
#define PG8_SA(b, h) (((b) * 2 + (h)) * HTB)
#define PG8_SB(b, h) ((4 + (b) * 2 + (h)) * HTB)
#define PG8_STAGE(bufoff, gbase, voff) do { _Pragma("unroll") for (int _i = 0; _i < 2; ++_i) \
        __builtin_amdgcn_global_load_lds((const unsigned*)((const char*)(gbase) + (voff)[_i]), (PG8_LAS unsigned*)(lds + (bufoff) + ldsw + _i * 8192), 16, 0, 0); } while (0)
#define PG8_LDA(dst, b, h) do { _Pragma("unroll") for (int m = 0; m < 4; ++m) _Pragma("unroll") for (int k = 0; k < 2; ++k) dst[m][k] = *(const PG8_LAS bf16x8*)(lds + PG8_SA(b, h) + aoff + m * 2048 + k * 1024); } while (0)
#define PG8_LDB(dst, b, h) do { _Pragma("unroll") for (int n = 0; n < 2; ++n) _Pragma("unroll") for (int k = 0; k < 2; ++k) dst[n][k] = *(const PG8_LAS bf16x8*)(lds + PG8_SB(b, h) + boff + n * 2048 + k * 1024); } while (0)
#define PG8_MMA(ai, bj, At, Bt) do { __builtin_amdgcn_s_setprio(1); _Pragma("unroll") for (int m = 0; m < 4; ++m) _Pragma("unroll") for (int n = 0; n < 2; ++n) _Pragma("unroll") for (int k = 0; k < 2; ++k) \
        acc[ai][bj][m][n] = __builtin_amdgcn_mfma_f32_16x16x32_bf16(Bt[n][k], At[m][k], acc[ai][bj][m][n], 0, 0, 0); __builtin_amdgcn_s_setprio(0); } while (0)
#define PG8_WAIT_V(n) asm volatile("s_waitcnt vmcnt(" #n ")" ::: "memory")
#define PG8_WAIT_L(n) asm volatile("s_waitcnt lgkmcnt(" #n ")" ::: "memory")
#define PG8_BAR __builtin_amdgcn_s_barrier()
#define PG8_SCHED __builtin_amdgcn_sched_barrier(0)
    Unit cur, nxt; int ui = 0;
    if (!S.next(0, cur)) return;
    f32x4 acc[2][2][4][2];
#pragma unroll
    for (int a = 0; a < 2; ++a)
#pragma unroll
        for (int b = 0; b < 2; ++b)
#pragma unroll
            for (int m = 0; m < 4; ++m)
#pragma unroll
                for (int n = 0; n < 2; ++n) acc[a][b][m][n] = (f32x4){0.f, 0.f, 0.f, 0.f};
    bf16x8 At[4][2], B0[2][2], B1[2][2];
    const char* cA = (const char*)g.A + (size_t)cur.pm * tstep; const char* cB = (const char*)g.Bt + (size_t)cur.pn * tstep;
    S.a_ready(cur);
    if constexpr (SP2) {
        PG8_STAGE(PG8_SB(0, 0), cB, voffB); PG8_STAGE(PG8_SB(0, 1), cB + hstep, voffB); PG8_STAGE(PG8_SA(0, 0), cA, voffA); PG8_STAGE(PG8_SA(0, 1), cA + hstep, voffA);
        if (wr == 1) PG8_BAR;
        PG8_WAIT_V(2); PG8_BAR;
        PG8_STAGE(PG8_SB(1, 0), cB + kstep, voffB); PG8_STAGE(PG8_SA(1, 0), cA + kstep, voffA); PG8_STAGE(PG8_SB(1, 1), cB + hstep + kstep, voffB);
        PG8_WAIT_V(6); PG8_BAR;
    } else {
        PG8_STAGE(PG8_SB(0, 0), cB, voffB); PG8_STAGE(PG8_SA(0, 0), cA, voffA); PG8_STAGE(PG8_SB(0, 1), cB + hstep, voffB); PG8_STAGE(PG8_SA(0, 1), cA + hstep, voffA);
        if (wr == 1) PG8_BAR;
        PG8_WAIT_V(4); PG8_BAR;
        PG8_STAGE(PG8_SB(1, 0), cB + kstep, voffB); PG8_STAGE(PG8_SA(1, 0), cA + kstep, voffA); PG8_STAGE(PG8_SB(1, 1), cB + hstep + kstep, voffB);
        PG8_WAIT_V(6); PG8_BAR;
    }
    for (;;) {
        const bool has_next = S.next(ui + 1, nxt);
        const char* nA = has_next ? (const char*)g.A + (size_t)nxt.pm * tstep : cA; const char* nB = has_next ? (const char*)g.Bt + (size_t)nxt.pn * tstep : cB;
        for (int t = 0; t < nt; t += 2) {
            const bool last = (t == nt - 2);
            const char* a1 = cA + (size_t)(t + 1) * kstep;
            const char* a2 = last ? nA : cA + (size_t)(t + 2) * kstep; const char* b2 = last ? nB : cB + (size_t)(t + 2) * kstep;
            const char* a3 = a2 + kstep; const char* b3 = b2 + kstep;
            if (last && has_next) S.a_ready(nxt);
            if constexpr (SP2) {
            PG8_LDB(B0, 0, 0); PG8_LDB(B1, 0, 1); PG8_SCHED; PG8_LDA(At, 0, 0); PG8_STAGE(PG8_SA(1, 1), a1 + hstep, voffA);
            PG8_WAIT_V(8); PG8_WAIT_L(0); PG8_BAR; PG8_MMA(0, 0, At, B0); PG8_MMA(0, 1, At, B1); PG8_BAR; PG8_SCHED;
            PG8_LDA(At, 0, 1); PG8_STAGE(PG8_SB(0, 0), b2, voffB); PG8_STAGE(PG8_SB(0, 1), b2 + hstep, voffB); PG8_STAGE(PG8_SA(0, 0), a2, voffA);
            PG8_WAIT_V(8); PG8_WAIT_L(0); PG8_BAR; PG8_MMA(1, 0, At, B0); PG8_MMA(1, 1, At, B1); PG8_BAR; PG8_SCHED;
            PG8_LDB(B0, 1, 0); PG8_LDB(B1, 1, 1); PG8_SCHED; PG8_LDA(At, 1, 0); PG8_STAGE(PG8_SA(0, 1), a2 + hstep, voffA);
            PG8_WAIT_V(8); PG8_WAIT_L(0); PG8_BAR; PG8_MMA(0, 0, At, B0); PG8_MMA(0, 1, At, B1); PG8_BAR; PG8_SCHED;
            PG8_LDA(At, 1, 1); PG8_STAGE(PG8_SB(1, 0), b3, voffB); PG8_STAGE(PG8_SB(1, 1), b3 + hstep, voffB); PG8_STAGE(PG8_SA(1, 0), a3, voffA);
            PG8_WAIT_V(8); PG8_WAIT_L(0); PG8_BAR; PG8_MMA(1, 0, At, B0); PG8_MMA(1, 1, At, B1); PG8_BAR; PG8_SCHED;
            } else {
            PG8_LDB(B0, 0, 0); PG8_SCHED; PG8_LDA(At, 0, 0); PG8_STAGE(PG8_SA(1, 1), a1 + hstep, voffA);
            PG8_WAIT_L(8); PG8_BAR; PG8_WAIT_L(0); PG8_MMA(0, 0, At, B0); PG8_BAR; PG8_SCHED;
            PG8_LDB(B1, 0, 1); PG8_STAGE(PG8_SB(0, 0), b2, voffB);
            PG8_BAR; PG8_WAIT_L(0); PG8_MMA(0, 1, At, B1); PG8_BAR;
            PG8_LDA(At, 0, 1); PG8_STAGE(PG8_SA(0, 0), a2, voffA);
            PG8_BAR; PG8_WAIT_L(0); PG8_MMA(1, 0, At, B0); PG8_BAR; PG8_SCHED;
            PG8_STAGE(PG8_SB(0, 1), b2 + hstep, voffB);
            PG8_WAIT_V(6); PG8_BAR; PG8_MMA(1, 1, At, B1); PG8_BAR;
            PG8_LDB(B0, 1, 0); PG8_SCHED; PG8_LDA(At, 1, 0); PG8_STAGE(PG8_SA(0, 1), a2 + hstep, voffA);
            PG8_WAIT_L(8); PG8_BAR; PG8_WAIT_L(0); PG8_MMA(0, 0, At, B0); PG8_BAR; PG8_SCHED;
            PG8_LDB(B1, 1, 1); PG8_STAGE(PG8_SB(1, 0), b3, voffB);
            PG8_BAR; PG8_WAIT_L(0); PG8_MMA(0, 1, At, B1); PG8_BAR;
            PG8_LDA(At, 1, 1); PG8_STAGE(PG8_SA(1, 0), a3, voffA);
            PG8_BAR; PG8_WAIT_L(0); PG8_MMA(1, 0, At, B0); PG8_BAR; PG8_SCHED;
            PG8_STAGE(PG8_SB(1, 1), b3 + hstep, voffB);
            PG8_WAIT_V(6); PG8_BAR; PG8_MMA(1, 1, At, B1); PG8_BAR;
            }
        }
        if constexpr (ALIGN_EPI) { if (wr == 0) PG8_BAR; }
        if constexpr (!Epi::AFTER_DRAIN) { E(acc, cur, wr, wc, fr, fq); S.done(cur); }
        if (!has_next) break;
#pragma unroll
        for (int a = 0; a < 2; ++a)
#pragma unroll
            for (int b = 0; b < 2; ++b)
#pragma unroll
                for (int m = 0; m < 4; ++m)
#pragma unroll
                    for (int n = 0; n < 2; ++n) acc[a][b][m][n] = (f32x4){0.f, 0.f, 0.f, 0.f};
        cur = nxt; cA = nA; cB = nB; ++ui;
        if constexpr (ALIGN_EPI) { if (wr == 1) PG8_BAR; }
    }
    PG8_WAIT_V(0);
    if constexpr (!ALIGN_EPI) { if (wr == 0) PG8_BAR; }
    PG8_BAR;
    if constexpr (Epi::AFTER_DRAIN) { E.fused(acc, cur, wr, wc, fr, fq, lds, wid, lane); S.done(cur); }
#undef PG8_SA
#undef PG8_SB
#undef PG8_STAGE
#undef PG8_LDA
#undef PG8_LDB
#undef PG8_MMA
#undef PG8_WAIT_V
#undef PG8_WAIT_L
#undef PG8_BAR
#undef PG8_SCHED
}
}

#define LAS __attribute__((address_space(3)))
typedef unsigned short bf16;
typedef unsigned v4u __attribute__((ext_vector_type(4)));
typedef float f32x4 __attribute__((ext_vector_type(4)));
typedef float f32x2 __attribute__((ext_vector_type(2)));
typedef float f32x16 __attribute__((ext_vector_type(16)));
typedef short bf16x8 __attribute__((ext_vector_type(8)));

constexpr int TT = 16384, DM = 2048, SEQ = 4096, NH = 8;
constexpr int INC = 11280;
constexpr int NP = 11264;
constexpr int DFF = 5632;
constexpr int C_MK = 1024, C_MV = 2048, C_DQ = 3072, C_DZ = 6144, C_GA = 7168, C_GB = 9216;
constexpr float EPS = 1e-6f;
constexpr float QSCALE = 0.08838834764831845f;
constexpr float QSCALE_L2E = 0.08838834764831845f * 1.4426950408889634f;

constexpr size_t MiB = 1u << 20;
constexpr size_t WS_W = 1 * MiB, WS_P = 128 * MiB, WS_R = 480 * MiB, WS_BG = 672 * MiB, WS_KM = 673 * MiB, WS_END = 674 * MiB;
constexpr size_t W_IN = 0, W_A = 23068672, W_B = 25165824, W_O = 27262976, W_FI = 31457280, W_FD = 54525952, W_BA = 66060288;
constexpr size_t R_H = 0, R_YA = 64 * MiB, R_YB = 96 * MiB, R_MG = 128 * MiB, R_ACT = 0, R_DQ = 0, R_DK = 32 * MiB, R_DV = 128 * MiB, R_TB = 160 * MiB, R_AB = 176 * MiB;

constexpr int NPH = 11;
constexpr int LDS_BYTES = 147456;

typedef float f32x2_t __attribute__((ext_vector_type(2)));
typedef __bf16 bf16x2_t __attribute__((ext_vector_type(2)));
__device__ __forceinline__ unsigned pk2(float lo, float hi) { f32x2_t v = {lo, hi}; bf16x2_t b = __builtin_convertvector(v, bf16x2_t); return __builtin_bit_cast(unsigned, b); }
__device__ __forceinline__ unsigned f2bf(float f) { return pk2(f, 0.f) & 0xffffu; }
__device__ __forceinline__ float bflo(unsigned u) { return __uint_as_float(u << 16); }
__device__ __forceinline__ float bfhi(unsigned u) { return __uint_as_float(u & 0xffff0000u); }
__device__ __forceinline__ float bf1(bf16 h) { return __uint_as_float(((unsigned)h) << 16); }
__device__ __forceinline__ float wave_sum(float v) {
#pragma unroll
    for (int o = 1; o < 64; o <<= 1) v += __shfl_xor(v, o);
    return v;
}
__device__ __forceinline__ float siluf_(float x) { return x * __builtin_amdgcn_rcpf(1.f + __expf(-x)); }
__device__ __forceinline__ int crow(int reg, int h) { return (reg & 3) + 8 * (reg >> 2) + 4 * h; }

typedef short s16x4 __attribute__((ext_vector_type(4)));
typedef short v4i16_t __attribute__((ext_vector_type(4)));
__device__ __forceinline__ s16x4 tr_read(LAS const unsigned char* p) { return __builtin_bit_cast(s16x4, __builtin_amdgcn_ds_read_tr16_b64_v4i16((LAS v4i16_t*)p)); }
__device__ __forceinline__ float bfs(short h) { return __uint_as_float(((unsigned)(unsigned short)h) << 16); }
typedef float f32x2_t __attribute__((ext_vector_type(2)));
typedef __bf16 bf16x2_t __attribute__((ext_vector_type(2)));
__device__ __forceinline__ unsigned cvtpk(float lo, float hi) { f32x2_t v = {lo, hi}; bf16x2_t b = __builtin_convertvector(v, bf16x2_t); return __builtin_bit_cast(unsigned, b); }

__device__ __forceinline__ void moba_item(LAS unsigned char* lds, const bf16* P, const float* KM, bf16* YA, int b, int h, int qb, int tid, int lane, int wave) {
    const int r = lane & 31, hh = lane >> 5;
    const size_t rowb = (size_t)b * SEQ;
    const int qin = 32 * wave + r;
    bf16x8 qf[8];
    { const bf16* qp = P + (rowb + qb * 256 + qin) * NP + h * 128 + 8 * hh;
#pragma unroll
      for (int st = 0; st < 8; ++st) qf[st] = *(const bf16x8*)(qp + 16 * st); }
    unsigned sel;
    if (qb <= 3) sel = (1u << qb) - 1u;
    else {
        float g1 = -INFINITY, g2 = -INFINITY, g3 = -INFINITY; int i1 = 0, i2 = 0, i3 = 0;
        for (int n = 0; n < qb; ++n) {
            const float* km = KM + ((size_t)(b * 8 + h) * 16 + n) * 128 + 8 * hh;
            float gs = 0.f;
#pragma unroll
            for (int st = 0; st < 8; ++st) { const f32x4 m0 = *(const f32x4*)(km + 16 * st), m1 = *(const f32x4*)(km + 16 * st + 4);
                gs += bfs(qf[st][0]) * m0.x + bfs(qf[st][1]) * m0.y + bfs(qf[st][2]) * m0.z + bfs(qf[st][3]) * m0.w
                    + bfs(qf[st][4]) * m1.x + bfs(qf[st][5]) * m1.y + bfs(qf[st][6]) * m1.z + bfs(qf[st][7]) * m1.w; }
            gs += __shfl_xor(gs, 32);
            if (gs > g1) { g3 = g2; i3 = i2; g2 = g1; i2 = i1; g1 = gs; i1 = n; }
            else if (gs > g2) { g3 = g2; i3 = i2; g2 = gs; i2 = n; }
            else if (gs > g3) { g3 = gs; i3 = n; }
        }
        sel = (1u << i1) | (1u << i2) | (1u << i3);
    }
    f32x16 o[4];
#pragma unroll
    for (int d = 0; d < 4; ++d)
#pragma unroll
        for (int i = 0; i < 16; ++i) o[d][i] = 0.f;
    float lsum = 0.f;
    const int key0 = tid >> 4, ch = tid & 15;
    const unsigned soff = (unsigned)(key0 * 256 + ((ch ^ (key0 & 15)) << 4));
    const bf16* gk = P + (rowb + key0) * NP + C_MK + h * 128 + 8 * ch;
    const int nt = 4 * qb + 4;
    v4u kr0, kr1, vr0, vr1;
    kr0 = *(const v4u*)gk; kr1 = *(const v4u*)(gk + (size_t)32 * NP); vr0 = *(const v4u*)(gk + 1024); vr1 = *(const v4u*)(gk + (size_t)32 * NP + 1024);
    *(LAS v4u*)(lds + soff) = kr0; *(LAS v4u*)(lds + soff + 8192) = kr1; *(LAS v4u*)(lds + 32768 + soff) = vr0; *(LAS v4u*)(lds + 32768 + soff + 8192) = vr1;
    __syncthreads();
    const unsigned kbase = (unsigned)(r * 256);
    const int q4 = (lane & 15) >> 2, p4 = lane & 3, grp = (lane >> 4) & 1;
    for (int t = 0; t < nt; ++t) {
        const int n = t >> 2, tt = t & 3; const bool own = (n == qb);
        const unsigned buf = (unsigned)(t & 1) * 16384u;
        if (t + 1 < nt) { const bf16* g2p = gk + (size_t)(t + 1) * 64 * NP;
            kr0 = *(const v4u*)g2p; kr1 = *(const v4u*)(g2p + (size_t)32 * NP); vr0 = *(const v4u*)(g2p + 1024); vr1 = *(const v4u*)(g2p + (size_t)32 * NP + 1024); }
        const bool mine = (sel >> n) & 1u;
        const bool active = own ? (64 * tt <= 32 * wave + 31) : (__ballot(mine) != 0ull);
        if (active) {
            f32x16 sT[2];
#pragma unroll
            for (int kt = 0; kt < 2; ++kt) {
#pragma unroll
                for (int i = 0; i < 16; ++i) sT[kt][i] = 0.f;
#pragma unroll
                for (int st = 0; st < 8; ++st) {
                    const bf16x8 kf = *(const LAS bf16x8*)(lds + buf + kbase + kt * 8192 + (((2 * st + hh) ^ (r & 15)) << 4));
                    sT[kt] = __builtin_amdgcn_mfma_f32_32x32x16_bf16(kf, qf[st], sT[kt], 0, 0, 0);
                }
            }
            bf16x8 pf[2][2];
#pragma unroll
            for (int kt = 0; kt < 2; ++kt) {
#pragma unroll
                for (int i = 0; i < 16; ++i) {
                    const int key = 64 * tt + 32 * kt + crow(i, hh);
                    const bool ok = own ? (key <= qin) : mine;
                    const float pv = ok ? __builtin_amdgcn_exp2f(sT[kt][i]) : 0.f;
                    lsum += pv; sT[kt][i] = pv;
                }
#pragma unroll
                for (int s = 0; s < 2; ++s) { v4u w; w.x = cvtpk(sT[kt][8 * s], sT[kt][8 * s + 1]); w.y = cvtpk(sT[kt][8 * s + 2], sT[kt][8 * s + 3]);
                    w.z = cvtpk(sT[kt][8 * s + 4], sT[kt][8 * s + 5]); w.w = cvtpk(sT[kt][8 * s + 6], sT[kt][8 * s + 7]); pf[kt][s] = __builtin_bit_cast(bf16x8, w); }
            }
#pragma unroll
            for (int dt = 0; dt < 4; ++dt) {
                const int chunk = 4 * dt + 2 * grp + (p4 >> 1);
#pragma unroll
                for (int kt = 0; kt < 2; ++kt)
#pragma unroll
                    for (int s = 0; s < 2; ++s) {
                        const int klo = 32 * kt + 16 * s + 4 * hh + q4, khi = klo + 8;
                        const s16x4 lo = tr_read(lds + 32768 + buf + klo * 256 + ((chunk ^ (klo & 15)) << 4) + 8 * (p4 & 1));
                        const s16x4 hi = tr_read(lds + 32768 + buf + khi * 256 + ((chunk ^ (khi & 15)) << 4) + 8 * (p4 & 1));
                        const bf16x8 vf = __builtin_shufflevector(lo, hi, 0, 1, 2, 3, 4, 5, 6, 7);
                        o[dt] = __builtin_amdgcn_mfma_f32_32x32x16_bf16(vf, pf[kt][s], o[dt], 0, 0, 0);
                    }
            }
        }
        if (t + 1 < nt) { const unsigned nb = (unsigned)((t + 1) & 1) * 16384u;
            *(LAS v4u*)(lds + nb + soff) = kr0; *(LAS v4u*)(lds + nb + soff + 8192) = kr1; *(LAS v4u*)(lds + 32768 + nb + soff) = vr0; *(LAS v4u*)(lds + 32768 + nb + soff + 8192) = vr1; }
        __syncthreads();
    }
    lsum += __shfl_xor(lsum, 32);
    const float inv = 1.f / lsum;
    bf16* yp = YA + (rowb + qb * 256 + qin) * 1024 + h * 128 + 4 * hh;
#pragma unroll
    for (int dt = 0; dt < 4; ++dt)
#pragma unroll
        for (int g = 0; g < 4; ++g) {
            unsigned long long w = (unsigned long long)cvtpk(o[dt][4 * g] * inv, o[dt][4 * g + 1] * inv) | ((unsigned long long)cvtpk(o[dt][4 * g + 2] * inv, o[dt][4 * g + 3] * inv) << 32);
            *(unsigned long long*)(yp + 32 * dt + 8 * g) = w;
        }
}

typedef unsigned v2u __attribute__((ext_vector_type(2)));
#define LBAR() do { asm volatile("s_waitcnt lgkmcnt(0)" ::: "memory"); __builtin_amdgcn_s_barrier(); asm volatile("" ::: "memory"); } while (0)
__device__ __forceinline__ int perm16(int o) { const int pc = o >> 2; return (o & 3) + 4 * ((pc == 1) ? 2 : ((pc == 2) ? 1 : pc)); }
template <int CTRL> __device__ __forceinline__ float dppf(float v) { return __builtin_bit_cast(float, __builtin_amdgcn_update_dpp(0, __builtin_bit_cast(int, v), CTRL, 0xf, 0xf, true)); }
__device__ __forceinline__ float bfe(const v4u& v, int e) { return (e & 1) ? bfhi(v[e >> 1]) : bflo(v[e >> 1]); }
__device__ __forceinline__ bf16x8 comb(v2u lo, v2u hi) { v4u w; w.x = lo.x; w.y = lo.y; w.z = hi.x; w.w = hi.y; return __builtin_bit_cast(bf16x8, w); }
__device__ __forceinline__ bf16x8 pack8(const f32x16& x, int s) { v4u w; w.x = cvtpk(x[8 * s], x[8 * s + 1]); w.y = cvtpk(x[8 * s + 2], x[8 * s + 3]); w.z = cvtpk(x[8 * s + 4], x[8 * s + 5]); w.w = cvtpk(x[8 * s + 6], x[8 * s + 7]); return __builtin_bit_cast(bf16x8, w); }

constexpr int DP_K = 4096, DP_Q = DP_K + 16384, DP_G = DP_Q + 16384, DP_B = DP_G + 256, DP_L = DP_B + 256, DP_T = DP_L + 16384, DP_A = DP_T + 8192, DP_W = DP_A + 8192;
__device__ __forceinline__ void dn_prep_phase(LAS unsigned char* lds, const bf16* P, const float* cw, bf16* DQ, bf16* DK, bf16* DV, const float* BETA, float* GG, bf16* TB, bf16* AB,
                                              int G, int tid0, int wave) {
    v4u raw[3][5]; float wpre[3]; float gpre = 0.f, bpre = 0.f;
#define DP_PREFETCH(item) do { const int b_ = (item) >> 9, h_ = ((item) >> 6) & 7, c_ = (item) & 63; const size_t rowb_ = (size_t)b_ * SEQ + c_ * 64; \
        int t_ = tid0; asm volatile("" : "+v"(t_)); const int rg_ = t_ >> 4, ch_ = t_ & 15, s0_ = c_ * 64 + 2 * rg_; \
        _Pragma("unroll") for (int x = 0; x < 3; ++x) _Pragma("unroll") for (int i = 0; i < 5; ++i) { \
            if (s0_ - 3 + i >= 0) raw[x][i] = *(const v4u*)(P + (rowb_ + 2 * rg_ + i - 3) * NP + C_DQ + x * 1024 + h_ * 128 + 8 * ch_); else raw[x][i] = (v4u){0u, 0u, 0u, 0u}; } \
        _Pragma("unroll") for (int j = 0; j < 3; ++j) { const int e = t_ + 512 * j, x = e >> 9, i = (e >> 7) & 3, d = e & 127; wpre[j] = cw[i * 3072 + x * 1024 + h_ * 128 + d]; } \
        if (wave == 0) { gpre = GG[(rowb_ + (t_ & 63)) * 8 + h_]; bpre = BETA[(rowb_ + (t_ & 63)) * 8 + h_]; } } while (0)
    int item = blockIdx.x;
    if (item < 2048) DP_PREFETCH(item);
    for (; item < 2048; item += G) {
        int tid = tid0; asm volatile("" : "+v"(tid));
        const int lane = tid & 63;
        const int b = item >> 9, h = (item >> 6) & 7, c = item & 63;
        const size_t rowb = (size_t)b * SEQ + c * 64;
#pragma unroll
        for (int j = 0; j < 3; ++j) ((LAS float*)(lds + DP_W))[tid + 512 * j] = wpre[j];
        LBAR();
        {
            const int rg = tid >> 4, ch = tid & 15;
#pragma unroll
            for (int x = 0; x < 3; ++x) {
                float a0[8], a1[8];
#pragma unroll
                for (int e = 0; e < 8; ++e) { a0[e] = 0.f; a1[e] = 0.f; }
#pragma unroll
                for (int i = 0; i < 4; ++i) { const LAS float* wp = (const LAS float*)(lds + DP_W) + (x * 4 + i) * 128 + 8 * ch; const f32x4 w0 = *(const LAS f32x4*)wp, w1 = *(const LAS f32x4*)(wp + 4);
#pragma unroll
                    for (int e = 0; e < 8; ++e) { const float wv = (e < 4) ? w0[e & 3] : w1[e & 3]; a0[e] += wv * bfe(raw[x][i], e); a1[e] += wv * bfe(raw[x][i + 1], e); } }
                float ss0 = 0.f, ss1 = 0.f;
#pragma unroll
                for (int e = 0; e < 8; ++e) { a0[e] = siluf_(a0[e]); a1[e] = siluf_(a1[e]); ss0 += a0[e] * a0[e]; ss1 += a1[e] * a1[e]; }
                if (x < 2) {
                    ss0 += dppf<0xB1>(ss0); ss1 += dppf<0xB1>(ss1); ss0 += dppf<0x4E>(ss0); ss1 += dppf<0x4E>(ss1);
                    ss0 += dppf<0x141>(ss0); ss1 += dppf<0x141>(ss1); ss0 += dppf<0x140>(ss0); ss1 += dppf<0x140>(ss1);
                    const float r0 = rsqrtf(ss0 + EPS) * (x == 0 ? QSCALE : 1.f), r1 = rsqrtf(ss1 + EPS) * (x == 0 ? QSCALE : 1.f);
#pragma unroll
                    for (int e = 0; e < 8; ++e) { a0[e] *= r0; a1[e] *= r1; }
                }
                v4u o0, o1;
                o0.x = cvtpk(a0[0], a0[1]); o0.y = cvtpk(a0[2], a0[3]); o0.z = cvtpk(a0[4], a0[5]); o0.w = cvtpk(a0[6], a0[7]);
                o1.x = cvtpk(a1[0], a1[1]); o1.y = cvtpk(a1[2], a1[3]); o1.z = cvtpk(a1[4], a1[5]); o1.w = cvtpk(a1[6], a1[7]);
                bf16* dst = (x == 0 ? DQ : (x == 1 ? DK : DV)) + (rowb + 2 * rg) * 1024 + h * 128 + 8 * ch;
                *(v4u*)dst = o0; *(v4u*)(dst + 1024) = o1;
                if (x < 2) { LAS unsigned char* base = lds + (x == 0 ? DP_Q : DP_K); const int row = 2 * rg;
                    *(LAS v4u*)(base + row * 256 + ((ch ^ (row & 15)) << 4)) = o0; *(LAS v4u*)(base + (row + 1) * 256 + ((ch ^ ((row + 1) & 15)) << 4)) = o1; }
            }
        }
        if (wave == 0) {
            float g = gpre;
#pragma unroll
            for (int d = 1; d < 64; d <<= 1) { const float v = __shfl_up(g, d); if (lane >= d) g += v; }
            GG[(rowb + lane) * 8 + h] = g; ((LAS float*)(lds + DP_G))[lane] = g; ((LAS float*)(lds + DP_B))[lane] = bpre;
        }
        if (item + G < 2048) DP_PREFETCH(item + G);
        LBAR();
        {
            const int r = lane & 31, hh = lane >> 5;
            const LAS float* Gs = (const LAS float*)(lds + DP_G); const LAS float* Bs = (const LAS float*)(lds + DP_B);
            LAS float* Ls = (LAS float*)(lds + DP_L); LAS bf16* As = (LAS bf16*)(lds + DP_A);
            if (wave < 6) {
                const int prod = wave / 3, tl = wave % 3, ti = (tl >= 1) ? 1 : 0, tj = (tl == 2) ? 1 : 0;
                const LAS unsigned char* Ab = lds + (prod == 0 ? DP_K : DP_Q) + (32 * ti + r) * 256; const LAS unsigned char* Bb = lds + DP_K + (32 * tj + r) * 256;
                f32x16 acc;
#pragma unroll
                for (int i = 0; i < 16; ++i) acc[i] = 0.f;
#pragma unroll
                for (int st = 0; st < 8; ++st) { const int sw = ((2 * st + hh) ^ (r & 15)) << 4;
                    acc = __builtin_amdgcn_mfma_f32_32x32x16_bf16(*(const LAS bf16x8*)(Ab + sw), *(const LAS bf16x8*)(Bb + sw), acc, 0, 0, 0); }
                const int j = 32 * tj + r; const float Gj = Gs[j];
#pragma unroll
                for (int idx = 0; idx < 16; ++idx) { const int i = 32 * ti + crow(idx, hh); const float dec = __expf(Gs[i] - Gj);
                    if (prod == 0) Ls[i * 64 + (j & 7) * 8 + (j >> 3)] = (i > j) ? Bs[i] * acc[idx] * dec : 0.f;
                    else As[i * 64 + (j & 48) + perm16(j & 15)] = (bf16)((i >= j) ? f2bf(acc[idx] * dec) : 0u); }
            } else if (wave == 6) {
#pragma unroll
                for (int e = 0; e < 4; ++e) { const int id = lane + 64 * e, i = id >> 3, q8 = id & 7; *(LAS f32x4*)(Ls + i * 64 + q8 * 8 + 4) = (f32x4){0.f, 0.f, 0.f, 0.f}; }
            } else {
#pragma unroll
                for (int e = 0; e < 8; ++e) *(LAS v4u*)(lds + DP_T + (lane + 64 * e) * 16) = (v4u){0u, 0u, 0u, 0u};
#pragma unroll
                for (int e = 0; e < 2; ++e) { const int id = lane + 64 * e, i = id >> 2, c4 = id & 3; *(LAS v4u*)(lds + DP_A + i * 128 + 64 + c4 * 16) = (v4u){0u, 0u, 0u, 0u}; }
            }
        }
        LBAR();
        {
            const int cl = lane >> 3, q8 = lane & 7, col = 8 * wave + cl;
            float xs[8];
#pragma unroll
            for (int k = 0; k < 8; ++k) xs[k] = 0.f;
            const LAS float* Lp = (const LAS float*)(lds + DP_L) + q8 * 8;
            LAS bf16* Ts = (LAS bf16*)(lds + DP_T);
#pragma unroll
            for (int i = 0; i < 64; ++i) {
                if (i >= 8 * wave) {
                    const f32x4 l0 = *(const LAS f32x4*)(Lp + i * 64), l1 = *(const LAS f32x4*)(Lp + i * 64 + 4);
                    float s = 0.f;
#pragma unroll
                    for (int kk = 0; kk < 8; ++kk) if (8 * kk < i) s += ((kk < 4) ? l0[kk & 3] : l1[kk & 3]) * xs[kk];
                    s += dppf<0xB1>(s); s += dppf<0x4E>(s); s += dppf<0x141>(s);
                    const float xi = ((i == col) ? 1.f : 0.f) - s;
                    if ((i & 7) == q8) { xs[i >> 3] = xi; Ts[i * 64 + (col & 48) + perm16(col & 15)] = (bf16)f2bf(xi); }
                }
            }
        }
        LBAR();
        { const size_t ib = (((size_t)(b * 8 + h)) * 64 + c) * 4096;
          *(v4u*)(TB + ib + tid * 8) = *(const LAS v4u*)(lds + DP_T + tid * 16); *(v4u*)(AB + ib + tid * 8) = *(const LAS v4u*)(lds + DP_A + tid * 16); }
    }
    LBAR();
#undef DP_PREFETCH
}

constexpr int SQ_K = 0, SQ_Q = 16384, SQ_V = 32768, SQ_T = 49152, SQ_A = 58368, SQ_EG = 67584, SQ_ED = 67904, SQ_BT = 68160, SQ_SZ = 68416;
__device__ __forceinline__ void dn_seq(LAS unsigned char* lds, const bf16* P, const bf16* DQ, const bf16* DK, const bf16* DV, const float* BETA, const float* GG, const bf16* TB, const bf16* AB,
                                       bf16* YB, const float* og, int b, int h, int tid, int lane, int wave) {
    const size_t rowb = (size_t)b * SEQ;
    const size_t ibh = ((size_t)(b * 8 + h)) * 64 * 4096;
    if (wave >= 4) {
        int lt = tid - 256;
        v4u rk[4], rq[4], rv[4], rt[2], ra[2]; float gG = 0.f, gB = 0.f;
#define DN_LOAD(c) do { asm volatile("" : "+v"(lt)); \
        _Pragma("unroll") for (int i = 0; i < 4; ++i) { const int e = lt + 256 * i, row = e >> 4, ch = e & 15; const size_t go = (rowb + (size_t)(c) * 64 + row) * 1024 + h * 128 + 8 * ch; \
            rk[i] = *(const v4u*)(DK + go); rq[i] = *(const v4u*)(DQ + go); rv[i] = *(const v4u*)(DV + go); } \
        _Pragma("unroll") for (int i = 0; i < 2; ++i) { const int e = lt + 256 * i; rt[i] = *(const v4u*)(TB + ibh + (size_t)(c) * 4096 + e * 8); ra[i] = *(const v4u*)(AB + ibh + (size_t)(c) * 4096 + e * 8); } \
        if (wave == 4) { gG = GG[(rowb + (size_t)(c) * 64 + lane) * 8 + h]; gB = BETA[(rowb + (size_t)(c) * 64 + lane) * 8 + h]; } } while (0)
#define DN_STORE(buf) do { asm volatile("" : "+v"(lt)); LAS unsigned char* bb = lds + (buf) * SQ_SZ; \
        _Pragma("unroll") for (int i = 0; i < 4; ++i) { const int e = lt + 256 * i, row = e >> 4, ch = e & 15; const int sw = row * 256 + ((ch ^ (row & 15)) << 4); \
            *(LAS v4u*)(bb + SQ_K + sw) = rk[i]; *(LAS v4u*)(bb + SQ_Q + sw) = rq[i]; *(LAS v4u*)(bb + SQ_V + row * 256 + ch * 16) = rv[i]; } \
        _Pragma("unroll") for (int i = 0; i < 2; ++i) { const int e = lt + 256 * i, row = e >> 3, c8 = e & 7; *(LAS v4u*)(bb + SQ_T + row * 144 + c8 * 16) = rt[i]; *(LAS v4u*)(bb + SQ_A + row * 144 + c8 * 16) = ra[i]; } \
        if (wave == 4) { const float gl = __shfl(gG, 63); ((LAS float*)(bb + SQ_EG))[lane] = __expf(gG); ((LAS float*)(bb + SQ_ED))[lane] = __expf(gl - gG); ((LAS float*)(bb + SQ_BT))[lane] = gB; \
            if (lane == 63) ((LAS float*)(bb + SQ_EG))[64] = __expf(gl); } } while (0)
        DN_LOAD(0); DN_STORE(0); DN_LOAD(1);
        LBAR();
        for (int c = 0; c < 64; ++c) {
            if (c + 1 < 64) { DN_STORE((c + 1) & 1); if (c + 2 < 64) DN_LOAD(c + 2); }
            asm volatile("" : "+v"(lt));
            const int orow = lt >> 2, oq = lt & 3;
            const size_t grow = rowb + (size_t)c * 64 + orow;
            v4u zr[4];
#pragma unroll
            for (int j = 0; j < 4; ++j) zr[j] = *(const v4u*)(P + grow * NP + C_DZ + h * 128 + 32 * oq + 8 * j);
            LBAR();
            {
                const LAS unsigned char* ob = lds + (c & 1) * SQ_SZ + SQ_V + orow * 256 + 64 * oq;
                v4u ov[4]; float ss = 0.f;
#pragma unroll
                for (int j = 0; j < 4; ++j) { ov[j] = *(const LAS v4u*)(ob + 16 * j);
#pragma unroll
                    for (int e = 0; e < 4; ++e) { const float x0 = bflo(ov[j][e]), x1 = bfhi(ov[j][e]); ss += x0 * x0 + x1 * x1; } }
                ss += dppf<0xB1>(ss); ss += dppf<0x4E>(ss);
                const float rinv = rsqrtf(ss * (1.f / 128) + EPS);
                bf16* yp = YB + grow * 1024 + h * 128 + 32 * oq;
#pragma unroll
                for (int j = 0; j < 4; ++j) { const f32x4 ga = *(const f32x4*)(og + 32 * oq + 8 * j), gb = *(const f32x4*)(og + 32 * oq + 8 * j + 4);
                    v4u w;
                    w.x = pk2(bflo(ov[j].x) * rinv * ga.x * siluf_(bflo(zr[j].x)), bfhi(ov[j].x) * rinv * ga.y * siluf_(bfhi(zr[j].x)));
                    w.y = pk2(bflo(ov[j].y) * rinv * ga.z * siluf_(bflo(zr[j].y)), bfhi(ov[j].y) * rinv * ga.w * siluf_(bfhi(zr[j].y)));
                    w.z = pk2(bflo(ov[j].z) * rinv * gb.x * siluf_(bflo(zr[j].z)), bfhi(ov[j].z) * rinv * gb.y * siluf_(bfhi(zr[j].z)));
                    w.w = pk2(bflo(ov[j].w) * rinv * gb.z * siluf_(bflo(zr[j].w)), bfhi(ov[j].w) * rinv * gb.w * siluf_(bfhi(zr[j].w)));
                    *(v4u*)(yp + 8 * j) = w; }
            }
            LBAR();
        }
#undef DN_LOAD
#undef DN_STORE
    } else {
        const int w = wave;
        f32x16 S[4];
#pragma unroll
        for (int kt = 0; kt < 4; ++kt)
#pragma unroll
            for (int i = 0; i < 16; ++i) S[kt][i] = 0.f;
        LBAR();
        for (int c = 0; c < 64; ++c) {
            int ln = lane; asm volatile("" : "+v"(ln));
            const int r = ln & 31, hh = ln >> 5, q4 = (ln & 15) >> 2, p4 = ln & 3, grp = (ln >> 4) & 1;
            const LAS unsigned char* bb = lds + (c & 1) * SQ_SZ;
            const LAS float* EG = (const LAS float*)(bb + SQ_EG); const LAS float* ED = (const LAS float*)(bb + SQ_ED); const LAS float* BT = (const LAS float*)(bb + SQ_BT);
            f32x16 ks[2], qs[2];
#pragma unroll
            for (int ti = 0; ti < 2; ++ti)
#pragma unroll
                for (int i = 0; i < 16; ++i) { ks[ti][i] = 0.f; qs[ti][i] = 0.f; }
            {
                const LAS unsigned char* kr0 = bb + SQ_K + r * 256; const LAS unsigned char* qr0 = bb + SQ_Q + r * 256;
                bf16x8 ka0, ka1, qa0, qa1;
                { const int off = ((0 + hh) ^ (r & 15)) << 4; ka0 = *(const LAS bf16x8*)(kr0 + off); ka1 = *(const LAS bf16x8*)(kr0 + 8192 + off); qa0 = *(const LAS bf16x8*)(qr0 + off); qa1 = *(const LAS bf16x8*)(qr0 + 8192 + off); }
#pragma unroll
                for (int it = 0; it < 8; ++it) {
                    bf16x8 kb0 = ka0, kb1 = ka1, qb0 = qa0, qb1 = qa1;
                    if (it < 7) { const int off = ((2 * (it + 1) + hh) ^ (r & 15)) << 4; kb0 = *(const LAS bf16x8*)(kr0 + off); kb1 = *(const LAS bf16x8*)(kr0 + 8192 + off); qb0 = *(const LAS bf16x8*)(qr0 + off); qb1 = *(const LAS bf16x8*)(qr0 + 8192 + off); }
                    const bf16x8 sf = pack8(S[it >> 1], it & 1);
                    ks[0] = __builtin_amdgcn_mfma_f32_32x32x16_bf16(ka0, sf, ks[0], 0, 0, 0);
                    qs[0] = __builtin_amdgcn_mfma_f32_32x32x16_bf16(qa0, sf, qs[0], 0, 0, 0);
                    ks[1] = __builtin_amdgcn_mfma_f32_32x32x16_bf16(ka1, sf, ks[1], 0, 0, 0);
                    qs[1] = __builtin_amdgcn_mfma_f32_32x32x16_bf16(qa1, sf, qs[1], 0, 0, 0);
                    ka0 = kb0; ka1 = kb1; qa0 = qb0; qa1 = qb1;
                }
            }
#pragma unroll
            for (int ti = 0; ti < 2; ++ti)
#pragma unroll
                for (int g = 0; g < 4; ++g) { const int t0 = 32 * ti + 8 * g + 4 * hh;
                    const s16x4 vv = tr_read(bb + SQ_V + (t0 + q4) * 256 + (32 * w + 16 * grp + 4 * p4) * 2);
                    const f32x4 eg = *(const LAS f32x4*)(EG + t0), bt = *(const LAS f32x4*)(BT + t0);
#pragma unroll
                    for (int e = 0; e < 4; ++e) { const int i = 4 * g + e; ks[ti][i] = bt[e] * (bfs(vv[e]) - eg[e] * ks[ti][i]); qs[ti][i] = eg[e] * qs[ti][i]; } }
            f32x16 vn[2];
#pragma unroll
            for (int ti = 0; ti < 2; ++ti)
#pragma unroll
                for (int i = 0; i < 16; ++i) vn[ti][i] = 0.f;
            {
                bf16x8 rf[2][2];
#pragma unroll
                for (int tj = 0; tj < 2; ++tj)
#pragma unroll
                    for (int s = 0; s < 2; ++s) rf[tj][s] = pack8(ks[tj], s);
                const LAS unsigned char* tr0 = bb + SQ_T + r * 144 + 16 * hh;
                bf16x8 tf[6];
#pragma unroll
                for (int s = 0; s < 2; ++s) { tf[s] = *(const LAS bf16x8*)(tr0 + 32 * s); tf[2 + s] = *(const LAS bf16x8*)(tr0 + 32 * 144 + 32 * s); tf[4 + s] = *(const LAS bf16x8*)(tr0 + 32 * 144 + 64 + 32 * s); }
#pragma unroll
                for (int s = 0; s < 2; ++s) {
                    vn[0] = __builtin_amdgcn_mfma_f32_32x32x16_bf16(tf[s], rf[0][s], vn[0], 0, 0, 0);
                    vn[1] = __builtin_amdgcn_mfma_f32_32x32x16_bf16(tf[2 + s], rf[0][s], vn[1], 0, 0, 0); }
#pragma unroll
                for (int s = 0; s < 2; ++s) vn[1] = __builtin_amdgcn_mfma_f32_32x32x16_bf16(tf[4 + s], rf[1][s], vn[1], 0, 0, 0);
            }
            bf16x8 df[2][2];
            {
                bf16x8 vf[2][2];
#pragma unroll
                for (int tj = 0; tj < 2; ++tj)
#pragma unroll
                    for (int s = 0; s < 2; ++s) vf[tj][s] = pack8(vn[tj], s);
                const LAS unsigned char* ar0 = bb + SQ_A + r * 144 + 16 * hh;
                bf16x8 af[6];
#pragma unroll
                for (int s = 0; s < 2; ++s) { af[s] = *(const LAS bf16x8*)(ar0 + 32 * s); af[2 + s] = *(const LAS bf16x8*)(ar0 + 32 * 144 + 32 * s); af[4 + s] = *(const LAS bf16x8*)(ar0 + 32 * 144 + 64 + 32 * s); }
#pragma unroll
                for (int s = 0; s < 2; ++s) {
                    qs[0] = __builtin_amdgcn_mfma_f32_32x32x16_bf16(af[s], vf[0][s], qs[0], 0, 0, 0);
                    qs[1] = __builtin_amdgcn_mfma_f32_32x32x16_bf16(af[2 + s], vf[0][s], qs[1], 0, 0, 0); }
#pragma unroll
                for (int s = 0; s < 2; ++s) qs[1] = __builtin_amdgcn_mfma_f32_32x32x16_bf16(af[4 + s], vf[1][s], qs[1], 0, 0, 0);
#pragma unroll
                for (int ti = 0; ti < 2; ++ti)
#pragma unroll
                    for (int g = 0; g < 4; ++g) { const f32x4 ed = *(const LAS f32x4*)(ED + 32 * ti + 8 * g + 4 * hh);
#pragma unroll
                        for (int e = 0; e < 4; ++e) vn[ti][4 * g + e] *= ed[e]; }
#pragma unroll
                for (int tj = 0; tj < 2; ++tj)
#pragma unroll
                    for (int s = 0; s < 2; ++s) df[tj][s] = pack8(vn[tj], s);
            }
            {
                LAS bf16* op = (LAS bf16*)(lds + (c & 1) * SQ_SZ + SQ_V) + 32 * w + r;
#pragma unroll
                for (int ti = 0; ti < 2; ++ti)
#pragma unroll
                    for (int i = 0; i < 16; ++i) op[(32 * ti + crow(i, hh)) * 128] = (bf16)f2bf(qs[ti][i]);
            }
            LBAR();
            {
                const float egl = EG[64];
#pragma unroll
                for (int kt = 0; kt < 4; ++kt)
#pragma unroll
                    for (int i = 0; i < 16; ++i) S[kt][i] *= egl;
                const int pp = (p4 == 1) ? 2 : ((p4 == 2) ? 1 : p4);
                const int cb = 2 * grp + (pp >> 1), b8 = 8 * (pp & 1);
                s16x4 lo[4], hi[4];
#define DN_KT_LOAD(tj, s) do { const int klo = 32 * (tj) + 16 * (s) + 4 * hh + q4, khi = klo + 8; \
                _Pragma("unroll") for (int kt = 0; kt < 4; ++kt) { lo[kt] = tr_read(bb + SQ_K + klo * 256 + (((4 * kt + cb) ^ (klo & 15)) << 4) + b8); hi[kt] = tr_read(bb + SQ_K + khi * 256 + (((4 * kt + cb) ^ (khi & 15)) << 4) + b8); } } while (0)
                DN_KT_LOAD(0, 0);
#pragma unroll
                for (int it = 0; it < 4; ++it) {
                    bf16x8 kf[4];
#pragma unroll
                    for (int kt = 0; kt < 4; ++kt) kf[kt] = __builtin_shufflevector(lo[kt], hi[kt], 0, 1, 2, 3, 4, 5, 6, 7);
                    if (it < 3) DN_KT_LOAD((it + 1) >> 1, (it + 1) & 1);
#pragma unroll
                    for (int kt = 0; kt < 4; ++kt) S[kt] = __builtin_amdgcn_mfma_f32_32x32x16_bf16(kf[kt], df[it >> 1][it & 1], S[kt], 0, 0, 0);
                }
#undef DN_KT_LOAD
            }
            LBAR();
        }
    }
}

#define XB_TMO      128
#define XB_XCNT(j)  (256  + 64 * (j))
#define XB_XSUB(j)  (1280 + 64 * (j))
#define XB_XGEN(j)  (2304 + 64 * (j))
#define XB_TOP      3328
#define XB_TOPGEN   3392
#define XCD_BAR_WORDS 3456
#define XB_SPIN_CAP (1u << 18)

__device__ __forceinline__ unsigned xb_ld(unsigned* p)              { return __hip_atomic_load(p, __ATOMIC_RELAXED, __HIP_MEMORY_SCOPE_AGENT); }
__device__ __forceinline__ unsigned xb_add(unsigned* p, unsigned v) { return __hip_atomic_fetch_add(p, v, __ATOMIC_RELAXED, __HIP_MEMORY_SCOPE_AGENT); }
__device__ __forceinline__ unsigned xb_xcc_id() { return (unsigned)__builtin_amdgcn_s_getreg((3 << 11) | 20) & 0xFu; }
#define XB_SPIN(cond, bar) do { unsigned _sp = 0; while (cond) { __builtin_amdgcn_s_sleep(1); \
    if ((++_sp & 255u) == 0u) { if (xb_ld(&(bar)[XB_TMO])) break; if (_sp > XB_SPIN_CAP) { atomicAdd(&(bar)[XB_TMO], 1u); break; } } } } while (0)

struct XcdBarrier {
    unsigned* bar; unsigned x;
    volatile LAS unsigned* st;
};

__device__ __forceinline__ XcdBarrier xcd_barrier_post(unsigned* bar, volatile LAS unsigned* st) {
    XcdBarrier b; b.bar = bar; b.x = xb_xcc_id(); b.st = st;
    if (threadIdx.x == 0) (void)xb_add(&bar[XB_XCNT(b.x)], 1u);
    return b;
}
__device__ __forceinline__ void xcd_barrier_complete(unsigned* bar, unsigned x, unsigned& nloc, unsigned& nx) {
    const unsigned G = gridDim.x * gridDim.y * gridDim.z;
    unsigned sum, cnt, mine, sp = 0u;
    for (;;) {
        sum = 0u; cnt = 0u; mine = 0u;
#pragma unroll
        for (unsigned j = 0; j < 16; ++j) { const unsigned c = xb_ld(&bar[XB_XCNT(j)]); sum += c; cnt += (c > 0u) ? 1u : 0u; mine = (j == x) ? c : mine; }
        if (sum == G) break;
        __builtin_amdgcn_s_sleep(1);
        if ((++sp & 255u) == 0u) { if (xb_ld(&bar[XB_TMO])) break; if (sp > XB_SPIN_CAP) { atomicAdd(&bar[XB_TMO], 1u); break; } }
    }
    nloc = mine > 0u ? mine : 1u; nx = cnt > 0u ? cnt : 1u;
}

__device__ __forceinline__ void xcd_barrier(const XcdBarrier& b) {
    asm volatile("s_waitcnt vmcnt(0)" ::: "memory");
    __syncthreads();
    if (threadIdx.x == 0) {
        unsigned* bar = b.bar;
        __builtin_amdgcn_s_waitcnt(0);
        unsigned nloc = b.st[0], nx = b.st[1];
        if (nloc == 0u) { xcd_barrier_complete(bar, b.x, nloc, nx); b.st[0] = nloc; b.st[1] = nx; }
        const unsigned old = xb_add(&bar[XB_XSUB(b.x)], 1u);
        const unsigned gen = old / nloc;
        if (old + 1u == (gen + 1u) * nloc) {
            __builtin_amdgcn_fence(__ATOMIC_RELEASE, "agent");
            asm volatile("s_waitcnt vmcnt(0)" ::: "memory");
            const unsigned og = xb_add(&bar[XB_TOP], 1u);
            const unsigned tg = og / nx;
            if (og + 1u == (tg + 1u) * nx) xb_add(&bar[XB_TOPGEN], 1u);
            else XB_SPIN(xb_ld(&bar[XB_TOPGEN]) == tg, bar);
            __builtin_amdgcn_fence(__ATOMIC_ACQUIRE, "agent");
            xb_add(&bar[XB_XGEN(b.x)], 1u);
            asm volatile("s_waitcnt vmcnt(0)" ::: "memory");
        } else {
            XB_SPIN(xb_ld(&bar[XB_XGEN(b.x)]) == gen, bar);
            __builtin_amdgcn_fence(__ATOMIC_ACQUIRE, "agent");
            asm volatile("s_waitcnt vmcnt(0)" ::: "memory");
        }
    }
    __syncthreads();
}

struct Args { const float* in[17]; float* out; unsigned char* ws; int ph_lo, ph_hi; };

__device__ __forceinline__ void transpose_item(const float* W, int ldw, int K, bf16* WT, int item, int nblk, int split, LAS float* scr, int lane) {
    const int kb = item / nblk, nb = item % nblk, k0 = 64 * kb, n0 = 32 * nb;
    const int s0 = (split == 2) ? ((nb >> 2) & 1) * DFF + 128 * (nb >> 3) + 32 * (nb & 3)
                                : n0 + ((split == 1 && n0 >= C_GA) ? 16 : 0);
#pragma unroll 8
    for (int i = 0; i < 32; ++i) { const int kk = 2 * i + (lane >> 5); scr[kk * 33 + (lane & 31)] = W[(size_t)(k0 + kk) * ldw + s0 + (lane & 31)]; }
    asm volatile("s_waitcnt lgkmcnt(0)" ::: "memory");
    const int c = lane & 7;
#pragma unroll
    for (int j = 0; j < 4; ++j) { const int n = (lane >> 3) + 8 * j; const LAS float* s = scr + (8 * c) * 33 + n;
        v4u o; o.x = pk2(s[0 * 33], s[1 * 33]); o.y = pk2(s[2 * 33], s[3 * 33]); o.z = pk2(s[4 * 33], s[5 * 33]); o.w = pk2(s[6 * 33], s[7 * 33]);
        *(v4u*)(WT + (size_t)(n0 + n) * K + k0 + 8 * c) = o; }
    asm volatile("s_waitcnt lgkmcnt(0)" ::: "memory");
}

__device__ __forceinline__ void rms_row(const float* xrow, const float* gain, bf16* orow, int lane) {
    const f32x4* xr = (const f32x4*)xrow + lane;
    f32x4 v[8]; float s = 0.f;
#pragma unroll
    for (int j = 0; j < 8; ++j) { v[j] = xr[64 * j]; s += (v[j].x * v[j].x + v[j].y * v[j].y) + (v[j].z * v[j].z + v[j].w * v[j].w); }
    const float rinv = rsqrtf(wave_sum(s) * (1.f / DM) + EPS);
    const f32x4* gp = (const f32x4*)gain + lane;
    unsigned long long* o8 = (unsigned long long*)orow + lane;
#pragma unroll
    for (int j = 0; j < 8; ++j) { const f32x4 g = gp[64 * j];
        o8[64 * j] = (unsigned long long)pk2(v[j].x * rinv * g.x, v[j].y * rinv * g.y) | ((unsigned long long)pk2(v[j].z * rinv * g.z, v[j].w * rinv * g.w) << 32); }
}

__device__ __forceinline__ void rms_row_bf16(const bf16* xrow, const float* gain, bf16* orow, int lane) {
    const v4u* xr = (const v4u*)xrow + lane;
    v4u v[4]; float s = 0.f;
#pragma unroll
    for (int j = 0; j < 4; ++j) { v[j] = xr[64 * j];
#pragma unroll
        for (int e = 0; e < 4; ++e) { const float a = bflo(v[j][e]), b = bfhi(v[j][e]); s += a * a + b * b; } }
    const float rinv = rsqrtf(wave_sum(s) * (1.f / DM) + EPS);
    v4u* o = (v4u*)orow + lane;
#pragma unroll
    for (int j = 0; j < 4; ++j) { const f32x4 g0 = *(const f32x4*)(gain + 8 * (lane + 64 * j)), g1 = *(const f32x4*)(gain + 8 * (lane + 64 * j) + 4);
        v4u w; w.x = pk2(bflo(v[j].x) * rinv * g0.x, bfhi(v[j].x) * rinv * g0.y); w.y = pk2(bflo(v[j].y) * rinv * g0.z, bfhi(v[j].y) * rinv * g0.w);
        w.z = pk2(bflo(v[j].z) * rinv * g1.x, bfhi(v[j].z) * rinv * g1.y); w.w = pk2(bflo(v[j].w) * rinv * g1.z, bfhi(v[j].w) * rinv * g1.w);
        o[64 * j] = w; }
}

__global__ void __launch_bounds__(512, 2) mega(Args a) {
    extern __shared__ __attribute__((aligned(16))) unsigned char lds_raw[];
    cg::grid_group grid = cg::this_grid();
    LAS unsigned char* lds = (LAS unsigned char*)lds_raw;
    const int G = gridDim.x, NGW = G * 8;
    unsigned char* ws = a.ws;
    bf16* WB = (bf16*)(ws + WS_W);
    bf16* P = (bf16*)(ws + WS_P);
    bf16* H = (bf16*)(ws + WS_R + R_H);
    bf16* YA = (bf16*)(ws + WS_R + R_YA);
    bf16* YB = (bf16*)(ws + WS_R + R_YB);
    bf16* MG = (bf16*)(ws + WS_R + R_MG);
    bf16* XM = (bf16*)(ws + WS_R + R_YA);
    bf16* ACT = (bf16*)(ws + WS_P);
    bf16* PRAW = (bf16*)(ws + WS_P + 180 * MiB);
    bf16* DQ = (bf16*)(ws + WS_R + R_DQ);
    bf16* DK = (bf16*)(ws + WS_R + R_DK);
    bf16* DV = (bf16*)(ws + WS_R + R_DV);
    bf16* TB = (bf16*)(ws + WS_R + R_TB);
    bf16* AB = (bf16*)(ws + WS_R + R_AB);
    float* BETA = (float*)(ws + WS_BG);
    float* GG = BETA + (size_t)TT * 8;
    float* KM = (float*)(ws + WS_KM);
    volatile LAS unsigned* bst = (volatile LAS unsigned*)(lds + LDS_BYTES - 16);
    if (threadIdx.x < 4) bst[threadIdx.x] = 0u;
    __syncthreads();
    const XcdBarrier xbar = xcd_barrier_post((unsigned*)(ws + 65536), bst);
    unsigned* ctr = (unsigned*)ws;
    if (blockIdx.x == 0 && threadIdx.x == 0 && a.ph_lo == 0) { ctr[0] = 0u; ctr[1] = 0u; ctr[2] = 0u; ctr[3] = 0u; }

#ifndef PROBE_MASK
#define PROBE_MASK 0
#endif
    for (int it = 2 * a.ph_lo; it < 2 * a.ph_hi; ++it) {
        const int ph = it >> 1, rep = it & 1;
        const int l = ph / NPH, p = ph % NPH;
        if (rep == 1 && !((PROBE_MASK >> p) & 1)) continue;
        if (p == 4) continue;
        int tid = threadIdx.x; asm volatile("" : "+v"(tid));
        const int lane = tid & 63, wave = __builtin_amdgcn_readfirstlane(tid >> 6), gw = blockIdx.x * 8 + wave;
        const float* xin = (l == 0) ? a.in[0] : a.out;

        if (p == 0) {
            LAS float* scr = (LAS float*)(lds + wave * 16384);
            const float* w_in = a.in[2] + (size_t)l * DM * INC;
            const float* w_a = a.in[9] + (size_t)l * 1024 * DM;
            const float* w_b = a.in[10] + (size_t)l * 1024 * DM;
            const float* w_o = a.in[11] + (size_t)l * DM * DM;
            const float* w_fi = a.in[13] + (size_t)l * DM * NP;
            const float* w_fd = a.in[16] + (size_t)l * DFF * DM;
            constexpr int I_IN = 32 * 352, I_BA = 32;
            for (int it = gw; it < I_IN + I_BA; it += NGW) {
                if (it < I_IN) transpose_item(w_in, INC, DM, WB + W_IN, it, 352, 1, scr, lane);
                else transpose_item(w_in + C_GA, INC, DM, WB + W_BA, it - I_IN, 1, 0, scr, lane);
            }
            const float* gain = a.in[1] + (size_t)l * DM;
            for (int row = gw; row < TT; row += NGW) rms_row(xin + (size_t)row * DM, gain, H + (size_t)row * DM, lane);
        }
        else if (p == 1 || p == 8) {
            pg8::Gemm g{H, WB + (p == 1 ? W_IN : W_FI), TT, NP, DM}; pg8::StaticOrder S; S.init(TT, NP, G, (int)blockIdx.x);
            if (p == 1) { pg8::EpiProj E{P, NP, a.in[3] + l * 128, a.in[4] + l * 128, KM, (LAS float*)(lds + 131072), QSCALE_L2E, EPS}; pg8::gemm_phase<pg8::EpiProj, pg8::StaticOrder, true, true>(lds, g, S, E); }
            else { pg8::EpiGLU E{ACT, PRAW, a.in[14] + (size_t)l * 3 * DFF, a.in[15] + (size_t)l * DFF, (LAS float*)(lds + 131072)};
                   pg8::gemm_phase<pg8::EpiGLU, pg8::StaticOrder, true, true>(lds, g, S, E); }
            if (p == 1) {
            __syncthreads();
            for (int tp = blockIdx.x; tp < TT / 64; tp += G) {
                const int r = lane & 31, hh = lane >> 5, tile = 2 * tp + (wave >> 2), kq = wave & 3;
                const float* alog = a.in[6] + l * 8; const float* dtb = a.in[7] + l * 8;
                const bf16* ap = H + (size_t)(tile * 32 + r) * DM + 512 * kq + 8 * hh;
                const bf16* bp = WB + W_BA + (size_t)r * DM + 512 * kq + 8 * hh;
                f32x16 acc;
#pragma unroll
                for (int i = 0; i < 16; ++i) acc[i] = 0.f;
#pragma unroll 16
                for (int k0 = 0; k0 < 512; k0 += 16) {
                    const bf16x8 av = *(const bf16x8*)(ap + k0); const bf16x8 bv = *(const bf16x8*)(bp + k0);
                    acc = __builtin_amdgcn_mfma_f32_32x32x16_bf16(av, bv, acc, 0, 0, 0);
                }
                LAS float* part = (LAS float*)lds + (wave * 64 + lane) * 16;
#pragma unroll
                for (int i = 0; i < 4; ++i) *(LAS f32x4*)(part + 4 * i) = (f32x4){acc[4 * i], acc[4 * i + 1], acc[4 * i + 2], acc[4 * i + 3]};
                __syncthreads();
                if (kq == 0 && r < 16) {
#pragma unroll
                    for (int q = 1; q < 4; ++q)
#pragma unroll
                        for (int i = 0; i < 4; ++i) { const f32x4 t = *(const LAS f32x4*)(part + q * 1024 + 4 * i); acc[4 * i] += t[0]; acc[4 * i + 1] += t[1]; acc[4 * i + 2] += t[2]; acc[4 * i + 3] += t[3]; }
                    const int hd = r & 7; const float A = __expf(alog[hd]), db = dtb[hd];
#pragma unroll
                    for (int i = 0; i < 16; ++i) { const int row = tile * 32 + crow(i, hh); const float v = acc[i];
                        if (r < 8) BETA[(size_t)row * 8 + hd] = 1.f / (1.f + __expf(-v));
                        else { const float z = v + db; const float sp = (z > 20.f) ? z : log1pf(__expf(z)); GG[(size_t)row * 8 + hd] = -A * sp; } }
                }
                __syncthreads();
            }
            }
        }
        else if (p == 2) {
            {
                const float* cw = a.in[5] + (size_t)l * 4 * 3072;
                dn_prep_phase(lds, P, cw, DQ, DK, DV, BETA, GG, TB, AB, G, tid, wave);
            }
        }
        else if (p == 3) {
            for (int item = blockIdx.x; item < 32; item += G) dn_seq(lds, P, DQ, DK, DV, BETA, GG, TB, AB, YB, a.in[8] + l * 128, item >> 3, item & 7, tid, lane, wave);
            __syncthreads();
            {
                LAS int* itemp = (LAS int*)(lds + LDS_BYTES - 32);
                constexpr int I_A = 16 * 64, I_O = 32 * 64, I_FI = 32 * 352, I_FD = 88 * 64, NFILL = (2 * I_A + I_O + I_FI + I_FD) / 32;
                for (;;) {
                    if (tid == 0) *itemp = (int)__hip_atomic_fetch_add(ctr + 2 * l + rep, 1u, __ATOMIC_RELAXED, __HIP_MEMORY_SCOPE_AGENT);
                    __syncthreads();
                    const int it = *itemp;
                    __syncthreads();
                    if (it >= 512 + NFILL) break;
                    if (it < 512) { const int qb = 15 - (it >> 5), bh = it & 31; moba_item(lds, P, KM, YA, bh >> 3, bh & 7, qb, tid, lane, wave); }
                    else {
                        LAS float* scr = (LAS float*)(lds + wave * 16384);
#pragma unroll 1
                        for (int j = 0; j < 4; ++j) { int r = (it - 512) * 32 + j * 8 + wave;
                            const float* W; int ldw, K, nblk, split; size_t doff;
                            if (r < I_A) { W = a.in[9] + (size_t)l * 1024 * DM; ldw = DM; K = 1024; nblk = 64; split = 0; doff = W_A; }
                            else if ((r -= I_A) < I_A) { W = a.in[10] + (size_t)l * 1024 * DM; ldw = DM; K = 1024; nblk = 64; split = 0; doff = W_B; }
                            else if ((r -= I_A) < I_O) { W = a.in[11] + (size_t)l * DM * DM; ldw = DM; K = DM; nblk = 64; split = 0; doff = W_O; }
                            else if ((r -= I_O) < I_FI) { W = a.in[13] + (size_t)l * DM * NP; ldw = NP; K = DM; nblk = 352; split = 2; doff = W_FI; }
                            else { r -= I_FI; W = a.in[16] + (size_t)l * DFF * DM; ldw = DM; K = DFF; nblk = 64; split = 0; doff = W_FD; }
                            transpose_item(W, ldw, K, WB + doff, r, nblk, split, scr, lane); }
                    }
                }
            }
        }
        else if (p == 4) {
            const float* og = a.in[8] + l * 128;
            const float og0 = og[2 * lane], og1 = og[2 * lane + 1];
            for (int idx = gw; idx < TT * 8; idx += NGW) {
                const int row = idx >> 3, h = idx & 7;
                const unsigned uo = *(const unsigned*)(P + (size_t)row * NP + C_DQ + h * 128 + 2 * lane);
                const unsigned uz = *(const unsigned*)(P + (size_t)row * NP + C_DZ + h * 128 + 2 * lane);
                const float o0 = bflo(uo), o1 = bfhi(uo);
                const float r = rsqrtf(wave_sum(o0 * o0 + o1 * o1) * (1.f / 128) + EPS);
                *(unsigned*)(YB + (size_t)row * 1024 + h * 128 + 2 * lane) = pk2(o0 * r * og0 * siluf_(bflo(uz)), o1 * r * og1 * siluf_(bfhi(uz)));
            }
        }
        else if (p == 5) {
            for (int pass = 0; pass < 2; ++pass) {
                pg8::Gemm g{pass ? YB : YA, WB + (pass ? W_B : W_A), TT, DM, 1024}; pg8::StaticOrder S; S.init(TT, DM, G, (int)blockIdx.x);
                pg8::EpiGate E{MG, DM, P + (pass ? C_GB : C_GA), NP, pass};
                pg8::gemm_phase<pg8::EpiGate, pg8::StaticOrder, true, true>(lds, g, S, E);
            }
        }
        else if (p == 6 || p == 10) {
            pg8::Gemm g{p == 6 ? MG : ACT, WB + (p == 6 ? W_O : W_FD), TT, DM, p == 6 ? DM : DFF}; pg8::StaticOrder S; S.init(TT, DM, G, (int)blockIdx.x);
            pg8::EpiResid E{xin, p == 6 ? (const bf16*)nullptr : (const bf16*)XM, a.out, p == 6 ? XM : (bf16*)nullptr, DM};
            pg8::gemm_phase<pg8::EpiResid, pg8::StaticOrder, true, true>(lds, g, S, E);
        }
        else if (p == 7) {
            const float* gain = a.in[12] + (size_t)l * DM;
            for (int row = gw; row < TT; row += NGW) rms_row_bf16(XM + (size_t)row * DM, gain, H + (size_t)row * DM, lane);
        }
        else if (p == 9) {
            const float* cw = a.in[14] + (size_t)l * 3 * DFF; const float* cb = a.in[15] + (size_t)l * DFF;
            for (int idx = blockIdx.x * 512 + tid; idx < 64 * (DFF / 8); idx += G * 512) {
                const int pm = idx / (DFF / 8), col = (idx % (DFF / 8)) * 8, t0 = pm * 256;
                if ((t0 & (SEQ - 1)) == 0) continue;
                float x[4][8], up[2][8];
#pragma unroll
                for (int i = 0; i < 4; ++i) { const v4u pg = *(const v4u*)(PRAW + (size_t)(i < 2 ? (pm - 1) * 4 + 2 + i : pm * 4 + i - 2) * NP + col);
#pragma unroll
                    for (int e = 0; e < 4; ++e) { x[i][2 * e] = bflo(pg[e]); x[i][2 * e + 1] = bfhi(pg[e]); } }
#pragma unroll
                for (int i = 0; i < 2; ++i) { const v4u pu = *(const v4u*)(PRAW + (size_t)(pm * 4 + i) * NP + DFF + col);
#pragma unroll
                    for (int e = 0; e < 4; ++e) { up[i][2 * e] = bflo(pu[e]); up[i][2 * e + 1] = bfhi(pu[e]); } }
#pragma unroll
                for (int i = 0; i < 2; ++i) { float r[8];
#pragma unroll
                    for (int e = 0; e < 8; ++e) { const float gt = cw[col + e] * x[i][e] + cw[DFF + col + e] * x[i + 1][e] + cw[2 * DFF + col + e] * x[i + 2][e] + cb[col + e]; r[e] = siluf_(gt) * up[i][e]; }
                    v4u w; w.x = pk2(r[0], r[1]); w.y = pk2(r[2], r[3]); w.z = pk2(r[4], r[5]); w.w = pk2(r[6], r[7]);
                    *(v4u*)(ACT + (size_t)(t0 + i) * DFF + col) = w; }
            }
        }
        if (it + 2 < 2 * a.ph_hi) xcd_barrier(xbar);
    }
    if (a.ph_lo > a.ph_hi) grid.sync();
}

extern "C" void kernel_launch(void* const* d_in, const int* in_sizes, int n_in, void* d_out, int out_size, void* d_ws, size_t ws_size, hipStream_t stream) {
    static int grid = 0;
    if (grid == 0) {
        if (n_in != 17 || out_size != TT * DM || ws_size < WS_END) { fprintf(stderr, "kernel_launch: unexpected shapes / workspace (%d inputs, out %d, ws %zu)\n", n_in, out_size, ws_size); grid = -1; return; }
        int dev = 0, cus = 0, per_cu = 0;
        if (hipGetDevice(&dev) != hipSuccess || hipDeviceGetAttribute(&cus, hipDeviceAttributeMultiprocessorCount, dev) != hipSuccess) { grid = -1; return; }
        if (hipFuncSetAttribute((const void*)mega, hipFuncAttributeMaxDynamicSharedMemorySize, LDS_BYTES) != hipSuccess) { grid = -1; return; }
        if (hipOccupancyMaxActiveBlocksPerMultiprocessor(&per_cu, (const void*)mega, 512, LDS_BYTES) != hipSuccess || per_cu < 1) { fprintf(stderr, "kernel_launch: occupancy query says %d\n", per_cu); per_cu = 1; }
        (void)hipGetLastError();
        grid = cus * per_cu;
    }
    if (grid < 0) return;
    Args a{};
    for (int i = 0; i < 17; ++i) a.in[i] = (const float*)d_in[i];
    a.out = (float*)d_out; a.ws = (unsigned char*)d_ws; a.ph_lo = 0; a.ph_hi = 2 * NPH;
    if (hipMemsetAsync(d_ws, 0, 128 * 1024, stream) != hipSuccess) { fprintf(stderr, "kernel_launch: memset of the control words failed\n"); return; }
    void* args[] = {&a};
    hipError_t e = hipLaunchCooperativeKernel((const void*)mega, dim3(grid), dim3(512), args, LDS_BYTES, stream);
    if (e != hipSuccess) fprintf(stderr, "cooperative launch failed: %s (grid %d)\n", hipGetErrorString(e), grid);
}
```
